# Optimizing an MI355X kernel written in HIP

```python
import math
import jax, jax.numpy as jnp
from jax import lax
import numpy as np

D_MODEL = 1024
BATCH = 16
SEQ = 4096
DEPTH = 4

N_META = 16
GRID_W = 64
HEAD_DIM = 64
BLOCK = 128
A_HEADS = 4
B_HEADS = 8
NA_ROWS_MAX = 8
NA_COLS = 16
C_HEADS = 8
C_KV_HEADS = 2
WINDOW = 128
T5_BUCKETS = 32
T5_MAX_DIST = 128
D_FF = 2816
N_BRANCH = 3
BRANCH_W = 512
A_COLS = 3 * A_HEADS * 2 * HEAD_DIM
B_COLS = 3 * B_HEADS * HEAD_DIM
C_COLS = (C_HEADS + 2 * C_KV_HEADS) * HEAD_DIM
IN_COLS = A_COLS + B_COLS + C_COLS
EPS = 1e-6
NEG = -1e30

kernel_name = "hybrid_gated_diff_natten_swa_encoder"


def rms_norm(x, g):
    xf = x.astype(jnp.float32)
    y = xf * lax.rsqrt(jnp.mean(xf * xf, axis=-1, keepdims=True) + EPS)
    return (y * g.astype(jnp.float32)).astype(x.dtype)


def swiglu(x, w_in, w_out):
    g, u = jnp.split(x @ w_in, 2, axis=-1)
    return (jax.nn.silu(g) * u) @ w_out


def t5_bucket(rel):
    nb = T5_BUCKETS // 2
    max_exact = nb // 2
    ret = jnp.where(rel > 0, nb, 0)
    n = jnp.abs(rel)
    nf = jnp.maximum(n, 1).astype(jnp.float32)
    large = max_exact + (jnp.log(nf / max_exact) / math.log(T5_MAX_DIST / max_exact)
                         * (nb - max_exact)).astype(jnp.int32)
    large = jnp.minimum(large, nb - 1)
    return ret + jnp.where(n < max_exact, n, large)


def t5_bias(table, rel):
    return jnp.moveaxis(table[t5_bucket(rel)], -1, 0).astype(jnp.float32)


def sink_softmax(s, sink):
    m = jnp.maximum(jnp.max(s, axis=-1, keepdims=True), sink)
    e = jnp.exp(s - m)
    return e / (jnp.sum(e, axis=-1, keepdims=True) + jnp.exp(sink - m))


def diff_attention(q, k, v, lam, lam_init, subln_g, table):
    bsz, L, H, _, dh = q.shape
    S = L - N_META
    nblk = S // BLOCK
    scale = dh ** -0.5
    kpos = jnp.arange(L)

    def attend(qb, qpos):
        s = jnp.einsum("bqhmd,bkhmd->bhmqk", qb, k).astype(jnp.float32) * scale
        s = s + t5_bias(table, kpos[None, :] - qpos[:, None])[None, :, None]
        p = jax.nn.softmax(s, axis=-1)
        a = p[:, :, 0] - lam * p[:, :, 1]
        return jnp.einsum("bhqk,bkhe->bqhe", a.astype(v.dtype), v)

    o_meta = attend(q[:, :N_META], jnp.arange(N_META))
    q_blocks = jnp.swapaxes(q[:, N_META:].reshape(bsz, nblk, BLOCK, H, 2, dh), 0, 1)
    pos_blocks = N_META + jnp.arange(S).reshape(nblk, BLOCK)
    o_real = lax.map(lambda a: attend(a[0], a[1]), (q_blocks, pos_blocks))
    o_real = jnp.swapaxes(o_real, 0, 1).reshape(bsz, S, H, 2 * dh)
    o = jnp.concatenate([o_meta, o_real], axis=1)
    o = rms_norm(o, subln_g) * (1.0 - lam_init)
    return o.reshape(bsz, L, H * 2 * dh)


def neighborhood_attention(q, k, v, rpb):
    bsz, L, H, dh = q.shape
    S = L - N_META
    rows = S // GRID_W
    wr = min(NA_ROWS_MAX, rows)
    scale = dh ** -0.5
    qm, km, vm = q[:, :N_META], k[:, :N_META], v[:, :N_META]
    qg = q[:, N_META:].reshape(bsz, rows, GRID_W, H, dh)
    kg = k[:, N_META:].reshape(bsz, rows, GRID_W, H, dh)
    vg = v[:, N_META:].reshape(bsz, rows, GRID_W, H, dh)

    cols = jnp.arange(GRID_W)
    cstart = jnp.clip(cols - NA_COLS // 2, 0, GRID_W - NA_COLS)
    col_ok = (cols[None, :] >= cstart[:, None]) & (cols[None, :] < cstart[:, None] + NA_COLS)
    col_idx = jnp.clip(cols[None, :] - cols[:, None] + NA_COLS - 1, 0, 2 * NA_COLS - 2)
    rb_cols = rpb[:, :, col_idx]

    def row(args):
        q_row, r = args
        rs = jnp.clip(r - wr // 2, 0, rows - wr)
        k_nb = lax.dynamic_slice_in_dim(kg, rs, wr, axis=1)
        v_nb = lax.dynamic_slice_in_dim(vg, rs, wr, axis=1)
        s = jnp.einsum("bchd,bxyhd->bhcxy", q_row, k_nb).astype(jnp.float32) * scale
        row_off = rs + jnp.arange(wr) - r + NA_ROWS_MAX - 1
        bias = jnp.transpose(rb_cols[:, row_off], (0, 2, 1, 3)).astype(jnp.float32)
        s = jnp.where(col_ok[:, None, :], s + bias[None], NEG).reshape(bsz, H, GRID_W, wr * GRID_W)
        sm = jnp.einsum("bchd,bmhd->bhcm", q_row, km).astype(jnp.float32) * scale
        p = jax.nn.softmax(jnp.concatenate([sm, s], axis=-1), axis=-1).astype(v.dtype)
        p_nb = p[..., N_META:].reshape(bsz, H, GRID_W, wr, GRID_W)
        return (jnp.einsum("bhcm,bmhd->bchd", p[..., :N_META], vm)
                + jnp.einsum("bhcxy,bxyhd->bchd", p_nb, v_nb))

    o_real = lax.map(row, (jnp.swapaxes(qg, 0, 1), jnp.arange(rows)))
    o_real = jnp.swapaxes(o_real, 0, 1).reshape(bsz, S, H, dh)

    k_org = kg[:, :wr, :NA_COLS].reshape(bsz, wr * NA_COLS, H, dh)
    v_org = vg[:, :wr, :NA_COLS].reshape(bsz, wr * NA_COLS, H, dh)
    k_mq = jnp.concatenate([km, k_org], axis=1)
    v_mq = jnp.concatenate([vm, v_org], axis=1)
    s_m = jnp.einsum("bqhd,bkhd->bhqk", qm, k_mq).astype(jnp.float32) * scale
    p_m = jax.nn.softmax(s_m, axis=-1).astype(v.dtype)
    o_meta = jnp.einsum("bhqk,bkhd->bqhd", p_m, v_mq)
    return jnp.concatenate([o_meta, o_real], axis=1).reshape(bsz, L, H * dh)


def window_gqa(q, k, v, sink, table):
    bsz, L, HQ, dh = q.shape
    KV = k.shape[2]
    G = HQ // KV
    S = L - N_META
    nblk = S // BLOCK
    scale = dh ** -0.5
    q = q.reshape(bsz, L, KV, G, dh)
    qm, km, vm = q[:, :N_META], k[:, :N_META], v[:, :N_META]
    sink_b = sink.astype(jnp.float32).reshape(KV, G, 1, 1)
    mpos = jnp.arange(N_META)

    pad = ((0, 0), (BLOCK, BLOCK), (0, 0), (0, 0))
    kp = jnp.pad(k[:, N_META:], pad)
    vp = jnp.pad(v[:, N_META:], pad)
    qi = jnp.arange(BLOCK)
    ki = jnp.arange(3 * BLOCK) - BLOCK
    rel = ki[None, :] - qi[:, None]
    band_bias = t5_bias(table, rel).reshape(KV, G, BLOCK, 3 * BLOCK)

    def block(args):
        qb, j = args
        kb = lax.dynamic_slice_in_dim(kp, j * BLOCK, 3 * BLOCK, axis=1)
        vb = lax.dynamic_slice_in_dim(vp, j * BLOCK, 3 * BLOCK, axis=1)
        kabs = j * BLOCK + ki
        valid = (jnp.abs(rel) <= WINDOW) & ((kabs >= 0) & (kabs < S))[None, :]
        s_b = jnp.einsum("bqkgd,bjkd->bkgqj", qb, kb).astype(jnp.float32) * scale + band_bias
        s_b = jnp.where(valid, s_b, NEG)
        qpos = N_META + j * BLOCK + qi
        s_m = (jnp.einsum("bqkgd,bmkd->bkgqm", qb, km).astype(jnp.float32) * scale
               + t5_bias(table, mpos[None, :] - qpos[:, None]).reshape(KV, G, BLOCK, N_META))
        p = sink_softmax(jnp.concatenate([s_m, s_b], axis=-1), sink_b).astype(v.dtype)
        return (jnp.einsum("bkgqm,bmkd->bqkgd", p[..., :N_META], vm)
                + jnp.einsum("bkgqj,bjkd->bqkgd", p[..., N_META:], vb))

    q_blocks = jnp.swapaxes(q[:, N_META:].reshape(bsz, nblk, BLOCK, KV, G, dh), 0, 1)
    o_real = lax.map(block, (q_blocks, jnp.arange(nblk)))
    o_real = jnp.swapaxes(o_real, 0, 1).reshape(bsz, S, KV, G, dh)

    k0 = k[:, N_META:N_META + BLOCK]
    v0 = v[:, N_META:N_META + BLOCK]
    rel0 = (N_META + jnp.arange(BLOCK))[None, :] - mpos[:, None]
    s_mm = (jnp.einsum("bqkgd,bmkd->bkgqm", qm, km).astype(jnp.float32) * scale
            + t5_bias(table, mpos[None, :] - mpos[:, None]).reshape(KV, G, N_META, N_META))
    s_m0 = (jnp.einsum("bqkgd,bjkd->bkgqj", qm, k0).astype(jnp.float32) * scale
            + t5_bias(table, rel0).reshape(KV, G, N_META, BLOCK))
    s_m0 = jnp.where(rel0 <= WINDOW, s_m0, NEG)
    p_m = sink_softmax(jnp.concatenate([s_mm, s_m0], axis=-1), sink_b).astype(v.dtype)
    o_meta = (jnp.einsum("bkgqm,bmkd->bqkgd", p_m[..., :N_META], vm)
              + jnp.einsum("bkgqj,bjkd->bqkgd", p_m[..., N_META:], v0))
    return jnp.concatenate([o_meta, o_real], axis=1).reshape(bsz, L, HQ * dh)


def token_mixer(xn, w_in, lam_q1, lam_k1, lam_q2, lam_k2, subln_g, rpb, sink, t5_table,
                w_branch, w_gate, w_out, lam_init):
    bsz, L, _ = xn.shape
    proj = xn @ w_in
    pa, pb, pc = jnp.split(proj, [A_COLS, A_COLS + B_COLS], axis=-1)

    qa, ka, va = jnp.split(pa, 3, axis=-1)
    qa = qa.reshape(bsz, L, A_HEADS, 2, HEAD_DIM)
    ka = ka.reshape(bsz, L, A_HEADS, 2, HEAD_DIM)
    va = va.reshape(bsz, L, A_HEADS, 2 * HEAD_DIM)
    f32 = jnp.float32
    lam = (jnp.exp(jnp.sum(lam_q1.astype(f32) * lam_k1.astype(f32)))
           - jnp.exp(jnp.sum(lam_q2.astype(f32) * lam_k2.astype(f32))) + lam_init)
    ya = diff_attention(qa, ka, va, lam, lam_init, subln_g, t5_table[:, :A_HEADS])

    qb, kb, vb = [t.reshape(bsz, L, B_HEADS, HEAD_DIM) for t in jnp.split(pb, 3, axis=-1)]
    yb = neighborhood_attention(qb, kb, vb, rpb)

    qc, kc, vc = jnp.split(pc, [C_HEADS * HEAD_DIM, (C_HEADS + C_KV_HEADS) * HEAD_DIM], axis=-1)
    qc = qc.reshape(bsz, L, C_HEADS, HEAD_DIM)
    kc = kc.reshape(bsz, L, C_KV_HEADS, HEAD_DIM)
    vc = vc.reshape(bsz, L, C_KV_HEADS, HEAD_DIM)
    yc = window_gqa(qc, kc, vc, sink, t5_table[:, A_HEADS:])

    merged = (jax.nn.sigmoid(xn @ w_gate[0]) * (ya @ w_branch[0])
              + jax.nn.sigmoid(xn @ w_gate[1]) * (yb @ w_branch[1])
              + jax.nn.sigmoid(xn @ w_gate[2]) * (yc @ w_branch[2]))
    return merged @ w_out


def setup_inputs(seed: int = 0) -> dict:
    key = jax.random.key(seed)
    ks = jax.random.split(key, 24)
    f32 = jnp.float32
    D = D_MODEL

    def nrm(k, shape, scale):
        return jax.random.normal(k, shape, f32) * scale

    def gain(k, shape):
        return 1.0 + 0.05 * jax.random.normal(k, shape, f32)

    return {
        "x": nrm(ks[0], (BATCH, SEQ, D), 1.0),
        "meta_tokens": nrm(ks[1], (N_META, D), 1.0),
        "t5_table": nrm(ks[2], (T5_BUCKETS, A_HEADS + C_HEADS), 0.5),
        "norm_ffn1": gain(ks[3], (DEPTH, D)),
        "w_ffn1_in": nrm(ks[4], (DEPTH, D, 2 * D_FF), D ** -0.5),
        "w_ffn1_out": nrm(ks[5], (DEPTH, D_FF, D), D_FF ** -0.5),
        "norm_mix": gain(ks[6], (DEPTH, D)),
        "w_in": nrm(ks[7], (DEPTH, D, IN_COLS), D ** -0.5),
        "lambda_q1": nrm(ks[8], (DEPTH, HEAD_DIM), 0.1),
        "lambda_k1": nrm(ks[9], (DEPTH, HEAD_DIM), 0.1),
        "lambda_q2": nrm(ks[10], (DEPTH, HEAD_DIM), 0.1),
        "lambda_k2": nrm(ks[11], (DEPTH, HEAD_DIM), 0.1),
        "subln_gain": gain(ks[12], (DEPTH, 2 * HEAD_DIM)),
        "natten_rpb": nrm(ks[13], (DEPTH, B_HEADS, 2 * NA_ROWS_MAX - 1, 2 * NA_COLS - 1), 0.5),
        "sink_logits": nrm(ks[14], (DEPTH, C_HEADS), 0.5),
        "w_branch": nrm(ks[15], (DEPTH, N_BRANCH, BRANCH_W, D), BRANCH_W ** -0.5),
        "w_gate": nrm(ks[16], (DEPTH, N_BRANCH, D, D), D ** -0.5),
        "w_out": nrm(ks[17], (DEPTH, D, D), D ** -0.5),
        "norm_ffn2": gain(ks[18], (DEPTH, D)),
        "w_ffn2_in": nrm(ks[19], (DEPTH, D, 2 * D_FF), D ** -0.5),
        "w_ffn2_out": nrm(ks[20], (DEPTH, D_FF, D), D_FF ** -0.5),
        "final_norm": gain(ks[21], (D,)),
    }


def reference(x, meta_tokens, t5_table, norm_ffn1, w_ffn1_in, w_ffn1_out, norm_mix, w_in,
              lambda_q1, lambda_k1, lambda_q2, lambda_k2, subln_gain, natten_rpb, sink_logits,
              w_branch, w_gate, w_out, norm_ffn2, w_ffn2_in, w_ffn2_out, final_norm):
    bsz = x.shape[0]
    meta = jnp.broadcast_to(meta_tokens[None].astype(x.dtype), (bsz, N_META, D_MODEL))
    h = jnp.concatenate([meta, x], axis=1)
    for l in range(DEPTH):
        lam_init = 0.8 - 0.6 * math.exp(-0.3 * l)
        h = h + 0.5 * swiglu(rms_norm(h, norm_ffn1[l]), w_ffn1_in[l], w_ffn1_out[l])
        h = h + token_mixer(rms_norm(h, norm_mix[l]), w_in[l], lambda_q1[l], lambda_k1[l],
                            lambda_q2[l], lambda_k2[l], subln_gain[l], natten_rpb[l], sink_logits[l],
                            t5_table, w_branch[l], w_gate[l], w_out[l], lam_init)
        h = h + 0.5 * swiglu(rms_norm(h, norm_ffn2[l]), w_ffn2_in[l], w_ffn2_out[l])
    return rms_norm(h, final_norm)[:, N_META:]
```

```cpp
#include <hip/hip_runtime.h>
#include <hip/hip_cooperative_groups.h>
#include <cstdio>
#include <cstdint>
namespace cg = cooperative_groups;

#define LAS __attribute__((address_space(3)))
typedef unsigned short bf16_t;
typedef short bf16x8 __attribute__((ext_vector_type(8)));
typedef short s16x4 __attribute__((ext_vector_type(4)));
typedef float f32x4 __attribute__((ext_vector_type(4)));
typedef float f32x16 __attribute__((ext_vector_type(16)));
typedef unsigned u32x4 __attribute__((ext_vector_type(4)));
typedef unsigned u32x2 __attribute__((ext_vector_type(2)));
typedef float f32x2_t __attribute__((ext_vector_type(2)));
typedef __bf16 bf16x2_t __attribute__((ext_vector_type(2)));

constexpr int DM = 1024, NBATCH = 16, SEQ = 4096, NMETA = 16, LT = SEQ + NMETA, MROWS = NBATCH * LT, DEPTH = 4, DFF = 2816, INC = 3840;
constexpr float EPS = 1e-6f, LOG2E = 1.4426950408889634f, NEGV = -1e30f;
static_assert(MROWS % 256 == 0, "rows");
constexpr size_t MiB = 1u << 20;
constexpr size_t OFF_SS = 0;
constexpr size_t OFF_HMETA = 9 * MiB;
constexpr size_t OFF_HB = 10 * MiB;
constexpr size_t OFF_W = 139 * MiB;
constexpr size_t OFF_Y = 191 * MiB;
constexpr size_t OFF_MG = 384 * MiB;
constexpr size_t OFF_R = 513 * MiB;
constexpr size_t WS_END = OFF_R + (size_t)MROWS * INC * 2;
static_assert(WS_END <= 1024 * MiB, "ws");
constexpr size_t WO_W1 = 0, WO_W2 = WO_W1 + (size_t)5632 * 1024, WO_WIN = WO_W2 + (size_t)1024 * 2816, WO_WG = WO_WIN + (size_t)3840 * 1024,
                 WO_WB = WO_WG + (size_t)3072 * 1024, WO_WO = WO_WB + (size_t)3 * 1024 * 512, WO_W3 = WO_WO + (size_t)1024 * 1024,
                 WO_W4 = WO_W3 + (size_t)5632 * 1024, WO_END = WO_W4 + (size_t)1024 * 2816;
static_assert(WO_END * 2 <= 52 * MiB, "weights");

__device__ __forceinline__ unsigned cvtpk(float lo, float hi) { f32x2_t v = {lo, hi}; bf16x2_t b = __builtin_convertvector(v, bf16x2_t); return __builtin_bit_cast(unsigned, b); }
__device__ __forceinline__ float bflo(unsigned u) { return __uint_as_float(u << 16); }
__device__ __forceinline__ float bfhi(unsigned u) { return __uint_as_float(u & 0xffff0000u); }

namespace pg8 {
constexpr int BM = 256, BK = 64, HALF = 128, HTB = HALF * BK * 2, STAGE_BYTES = 8 * HTB, NXCD = 8, WGM = 8;
__device__ __forceinline__ int lds_byte(int r, int c) { const int st = (r >> 4) * 2 + (c >> 5), rr = r & 15, cc = c & 31, ob = rr * 64 + cc * 2; return st * 1024 + (ob ^ (((ob >> 9) & 1) << 5)); }
__device__ __forceinline__ void stage_rc(int b, int& R, int& C) { const int st = b / 1024, sb = b % 1024, swz = sb ^ (((sb >> 9) & 1) << 5); R = (st >> 1) * 16 + swz / 64; C = (st & 1) * 32 + (swz % 64) / 2; }
__device__ __forceinline__ int perm32(int rho) { const int n = rho >> 4, i = rho & 15; return 8 * (i >> 2) + 4 * n + (i & 3); }
struct Unit { int pm, pn; };
struct Gemm { const bf16_t* A; const bf16_t* Bt; int M, N, K; };
struct StaticOrder {
    int nM, nN, nwg, G, c;
    __device__ void init(int M, int N, int G_, int c_) { nM = M / BM; nN = N / BM; nwg = nM * nN; G = G_; c = c_; }
    __device__ bool next(int i, Unit& u) const {
        const long L = (long)i * G + c; if (L >= nwg) return false;
        int wgid = (int)L; { const int q = nwg / NXCD, r = nwg % NXCD, xcd = wgid % NXCD, off = wgid / NXCD; wgid = (xcd < r ? xcd * (q + 1) : r * (q + 1) + (xcd - r) * q) + off; }
        const int nig = WGM * nN, gid = wgid / nig, fm = gid * WGM, gsz = (nM - fm) < WGM ? (nM - fm) : WGM;
        u.pm = fm + ((wgid % nig) % gsz); u.pn = (wgid % nig) / gsz; return true;
    }
};

struct BranchOrder { StaticOrder S;
    __device__ bool next(int i, Unit& u) const { const int bi = i / 3, gi = i - bi * 3; Unit b; if (!S.next(bi, b)) return false; u.pm = gi * 257 + b.pm; u.pn = gi * 4 + b.pn; return true; } };
template <class Epi, class Sched>
__device__ __forceinline__ void gemm_phase(LAS unsigned char* lds, const Gemm g, const Sched& S, const Epi& E) {
    int tid = threadIdx.x; asm volatile("" : "+v"(tid));
    const int wid = __builtin_amdgcn_readfirstlane(tid >> 6), lane = tid & 63, wr = wid >> 2, wc = wid & 3, fr = lane & 15, fq = lane >> 4;
    int K = g.K; const char* gA = (const char*)g.A; const char* gB = (const char*)g.Bt;
    asm volatile("" : "+s"(K), "+s"(gA), "+s"(gB));
    const int nt = K / BK;
    unsigned voffA[2], voffB[2];
#pragma unroll
    for (int i = 0; i < 2; ++i) { int R, C; stage_rc(tid * 16 + i * 8192, R, C); const int Rb = Epi::PERM ? ((R & ~31) + perm32(R & 31)) : R;
        voffA[i] = (unsigned)(R * K + C) * 2u; voffB[i] = (unsigned)(Rb * K + C) * 2u; }
    const size_t kstep = (size_t)(BK * 2);
    const size_t hstep = (size_t)HALF * K * 2;
    const size_t tstep = 2 * hstep;
    const unsigned ldsw = (unsigned)wid * 1024u;
    const int aoff = lds_byte(wr * 64 + fr, fq * 8), boff = lds_byte(wc * 32 + fr, fq * 8);
#define PG8_SA(b, h) (((b) * 2 + (h)) * HTB)
#define PG8_SB(b, h) ((4 + (b) * 2 + (h)) * HTB)
#define PG8_STAGE(bufoff, gbase, voff) do { _Pragma("unroll") for (int _i = 0; _i < 2; ++_i) \
        __builtin_amdgcn_global_load_lds((const unsigned*)((const char*)(gbase) + (voff)[_i]), (LAS unsigned*)(lds + (bufoff) + ldsw + _i * 8192), 16, 0, 0); } while (0)
#define PG8_LDA(dst, b, h) do { _Pragma("unroll") for (int m = 0; m < 4; ++m) _Pragma("unroll") for (int k = 0; k < 2; ++k) dst[m][k] = *(const LAS bf16x8*)(lds + PG8_SA(b, h) + aoff + m * 2048 + k * 1024); } while (0)
#define PG8_LDB(dst, b, h) do { _Pragma("unroll") for (int n = 0; n < 2; ++n) _Pragma("unroll") for (int k = 0; k < 2; ++k) dst[n][k] = *(const LAS bf16x8*)(lds + PG8_SB(b, h) + boff + n * 2048 + k * 1024); } while (0)
#define PG8_MMA(ai, bj, At, Bt) do { __builtin_amdgcn_s_setprio(1); _Pragma("unroll") for (int m = 0; m < 4; ++m) _Pragma("unroll") for (int n = 0; n < 2; ++n) _Pragma("unroll") for (int k = 0; k < 2; ++k) \
        acc[ai][bj][m][n] = __builtin_amdgcn_mfma_f32_16x16x32_bf16(Bt[n][k], At[m][k], acc[ai][bj][m][n], 0, 0, 0); __builtin_amdgcn_s_setprio(0); } while (0)
#define PG8_WAIT_V(n) asm volatile("s_waitcnt vmcnt(" #n ")" ::: "memory")
#define PG8_WAIT_L(n) asm volatile("s_waitcnt lgkmcnt(" #n ")" ::: "memory")
#define PG8_BAR __builtin_amdgcn_s_barrier()
#define PG8_SCHED __builtin_amdgcn_sched_barrier(0)
    Unit cur, nxt; int ui = 0;
    if (!S.next(0, cur)) return;
    f32x4 acc[2][2][4][2];
#pragma unroll
    for (int a = 0; a < 2; ++a)
#pragma unroll
        for (int b = 0; b < 2; ++b)
#pragma unroll
            for (int m = 0; m < 4; ++m)
#pragma unroll
                for (int n = 0; n < 2; ++n) acc[a][b][m][n] = (f32x4){0.f, 0.f, 0.f, 0.f};
    bf16x8 At[4][2], B0[2][2], B1[2][2];
    const char* cA = gA + (size_t)cur.pm * tstep; const char* cB = gB + (size_t)cur.pn * tstep;
    PG8_STAGE(PG8_SB(0, 0), cB, voffB); PG8_STAGE(PG8_SB(0, 1), cB + hstep, voffB); PG8_STAGE(PG8_SA(0, 0), cA, voffA); PG8_STAGE(PG8_SA(0, 1), cA + hstep, voffA);
    if (wr == 1) PG8_BAR;
    PG8_WAIT_V(2); PG8_BAR;
    PG8_STAGE(PG8_SB(1, 0), cB + kstep, voffB); PG8_STAGE(PG8_SA(1, 0), cA + kstep, voffA); PG8_STAGE(PG8_SB(1, 1), cB + hstep + kstep, voffB);
    PG8_WAIT_V(6); PG8_BAR;
    for (;;) {
        const bool has_next = S.next(ui + 1, nxt);
        const char* nA = has_next ? gA + (size_t)nxt.pm * tstep : cA; const char* nB = has_next ? gB + (size_t)nxt.pn * tstep : cB;
        for (int t = 0; t < nt; t += 2) {
            const bool last = (t == nt - 2);
            const char* a1 = cA + (size_t)(t + 1) * kstep;
            const char* a2 = last ? nA : cA + (size_t)(t + 2) * kstep; const char* b2 = last ? nB : cB + (size_t)(t + 2) * kstep;
            const char* a3 = a2 + kstep; const char* b3 = b2 + kstep;
            PG8_LDB(B0, 0, 0); PG8_LDB(B1, 0, 1); PG8_SCHED; PG8_LDA(At, 0, 0); PG8_STAGE(PG8_SA(1, 1), a1 + hstep, voffA);
            PG8_WAIT_V(8); PG8_WAIT_L(0); PG8_BAR; PG8_MMA(0, 0, At, B0); PG8_MMA(0, 1, At, B1); PG8_BAR; PG8_SCHED;
            PG8_LDA(At, 0, 1); PG8_STAGE(PG8_SB(0, 0), b2, voffB); PG8_STAGE(PG8_SB(0, 1), b2 + hstep, voffB); PG8_STAGE(PG8_SA(0, 0), a2, voffA);
            PG8_WAIT_V(8); PG8_WAIT_L(0); PG8_BAR; PG8_MMA(1, 0, At, B0); PG8_MMA(1, 1, At, B1); PG8_BAR; PG8_SCHED;
            PG8_LDB(B0, 1, 0); PG8_LDB(B1, 1, 1); PG8_SCHED; PG8_LDA(At, 1, 0); PG8_STAGE(PG8_SA(0, 1), a2 + hstep, voffA);
            PG8_WAIT_V(8); PG8_WAIT_L(0); PG8_BAR; PG8_MMA(0, 0, At, B0); PG8_MMA(0, 1, At, B1); PG8_BAR; PG8_SCHED;
            PG8_LDA(At, 1, 1); PG8_STAGE(PG8_SB(1, 0), b3, voffB); PG8_STAGE(PG8_SB(1, 1), b3 + hstep, voffB); PG8_STAGE(PG8_SA(1, 0), a3, voffA);
            PG8_WAIT_V(8); PG8_WAIT_L(0); PG8_BAR; PG8_MMA(1, 0, At, B0); PG8_MMA(1, 1, At, B1); PG8_BAR; PG8_SCHED;
        }
        if (wr == 0) PG8_BAR;
        E(acc, cur, wr, wc, fr, fq);
        if (!has_next) break;
#pragma unroll
        for (int a = 0; a < 2; ++a)
#pragma unroll
            for (int b = 0; b < 2; ++b)
#pragma unroll
                for (int m = 0; m < 4; ++m)
#pragma unroll
                    for (int n = 0; n < 2; ++n) acc[a][b][m][n] = (f32x4){0.f, 0.f, 0.f, 0.f};
        cur = nxt; cA = nA; cB = nB; ++ui;
        if (wr == 1) PG8_BAR;
    }
    PG8_WAIT_V(0);
    PG8_BAR;
#undef PG8_SA
#undef PG8_SB
#undef PG8_STAGE
#undef PG8_LDA
#undef PG8_LDB
#undef PG8_MMA
#undef PG8_WAIT_V
#undef PG8_WAIT_L
#undef PG8_BAR
#undef PG8_SCHED
}
}
using pg8::Unit;
typedef f32x4 AccT[2][2][4][2];

__device__ __forceinline__ float xsum_16_32(float v) {
    const auto a = __builtin_amdgcn_permlane16_swap(__float_as_uint(v), __float_as_uint(v), false, false); v = __uint_as_float(a[0]) + __uint_as_float(a[1]);
    const auto b = __builtin_amdgcn_permlane32_swap(__float_as_uint(v), __float_as_uint(v), false, false); return __uint_as_float(b[0]) + __uint_as_float(b[1]);
}
__device__ __forceinline__ float rstd_of(const float* ss, int row) {
    const f32x4* p = (const f32x4*)(ss + (size_t)row * 16); const f32x4 a = p[0], b = p[1], c = p[2], d = p[3];
    const float t = ((a[0] + a[1]) + (a[2] + a[3])) + ((b[0] + b[1]) + (b[2] + b[3])) + ((c[0] + c[1]) + (c[2] + c[3])) + ((d[0] + d[1]) + (d[2] + d[3]));
    return rsqrtf(t * (1.0f / DM) + EPS); }
__device__ __forceinline__ float* hrow(float* hout, float* hmeta, int row) {
    const int b = row / LT, t = row - b * LT;
    return t < NMETA ? hmeta + (size_t)(b * NMETA + t) * DM : hout + ((size_t)b * SEQ + (t - NMETA)) * DM;
}
__device__ __forceinline__ float rstd_coop(const float* ss, int row, int fq) {
    const f32x4 a = *(const f32x4*)(ss + (size_t)row * 16 + fq * 4); float t = (a[0] + a[1]) + (a[2] + a[3]);
    t = xsum_16_32(t);
    return rsqrtf(t * (1.0f / DM) + EPS); }
__device__ __forceinline__ float silu_f(float g) { return g * __builtin_amdgcn_rcpf(1.0f + __builtin_amdgcn_exp2f(-g * LOG2E)); }
__device__ __forceinline__ float sigm_f(float g) { return __builtin_amdgcn_rcpf(1.0f + __builtin_amdgcn_exp2f(-g * LOG2E)); }

struct EpiSwiGLU { static constexpr bool PERM = true; bf16_t* O; const float* ss;
    __device__ __forceinline__ void operator()(const AccT& acc, const Unit& u, int wr, int wc, int fr, int fq) const {
        const int row0 = u.pm * 256 + wr * 64 + fr, col0 = u.pn * 128 + wc * 32 + 8 * fq;
        float rsv[2][4];
        { f32x4 pv[2][4];
#pragma unroll
          for (int ai = 0; ai < 2; ++ai)
#pragma unroll
              for (int m = 0; m < 4; ++m) pv[ai][m] = *(const f32x4*)(ss + (size_t)(row0 + ai * 128 + m * 16) * 16 + fq * 4);
#pragma unroll
          for (int ai = 0; ai < 2; ++ai)
#pragma unroll
              for (int m = 0; m < 4; ++m) { const f32x4 a = pv[ai][m]; float t = (a[0] + a[1]) + (a[2] + a[3]); t = xsum_16_32(t); rsv[ai][m] = rsqrtf(t * (1.0f / DM) + EPS); } }
#pragma unroll
        for (int ai = 0; ai < 2; ++ai)
#pragma unroll
            for (int m = 0; m < 4; ++m) { const int row = row0 + ai * 128 + m * 16; const float rs = rsv[ai][m]; const float c1 = -rs * LOG2E, c2 = rs * rs;
                float a[8];
#pragma unroll
                for (int n = 0; n < 2; ++n)
#pragma unroll
                    for (int j = 0; j < 4; ++j) { const float g_ = acc[ai][0][m][n][j]; a[n * 4 + j] = (g_ * acc[ai][1][m][n][j]) * (c2 * __builtin_amdgcn_rcpf(1.0f + __builtin_amdgcn_exp2f(g_ * c1))); }
                u32x4 w; w.x = cvtpk(a[0], a[1]); w.y = cvtpk(a[2], a[3]); w.z = cvtpk(a[4], a[5]); w.w = cvtpk(a[6], a[7]);
                *(u32x4*)(O + (size_t)row * DFF + col0) = w; }
    }
};
struct EpiRes { static constexpr bool PERM = true; bf16_t* hb; float* ssn; float c;
    __device__ __forceinline__ void operator()(const AccT& acc, const Unit& u, int wr, int wc, int fr, int fq) const {
        const int row0 = u.pm * 256 + wr * 64 + fr, col0 = u.pn * 256 + wc * 32 + 8 * fq;
        bf16_t* bp0 = hb + (size_t)row0 * DM + col0;
        u32x4 hv[2][4][2];
#pragma unroll
        for (int ai = 0; ai < 2; ++ai)
#pragma unroll
            for (int m = 0; m < 4; ++m)
#pragma unroll
                for (int bj = 0; bj < 2; ++bj) hv[ai][m][bj] = *(const u32x4*)(bp0 + (size_t)(ai * 128 + m * 16) * DM + bj * 128);
#pragma unroll
        for (int ai = 0; ai < 2; ++ai)
#pragma unroll
            for (int m = 0; m < 4; ++m) { const int row = row0 + ai * 128 + m * 16; bf16_t* bp = bp0 + (size_t)(ai * 128 + m * 16) * DM; float q = 0.f;
#pragma unroll
                for (int bj = 0; bj < 2; ++bj) { const u32x4 h4 = hv[ai][m][bj];
                    f32x4 v0 = {bflo(h4.x), bfhi(h4.x), bflo(h4.y), bfhi(h4.y)}, v1 = {bflo(h4.z), bfhi(h4.z), bflo(h4.w), bfhi(h4.w)};
                    v0 = v0 + acc[ai][bj][m][0] * c; v1 = v1 + acc[ai][bj][m][1] * c;
                    q += ((v0[0] * v0[0] + v0[1] * v0[1]) + (v0[2] * v0[2] + v0[3] * v0[3])) + ((v1[0] * v1[0] + v1[1] * v1[1]) + (v1[2] * v1[2] + v1[3] * v1[3]));
                    u32x4 w; w.x = cvtpk(v0[0], v0[1]); w.y = cvtpk(v0[2], v0[3]); w.z = cvtpk(v1[0], v1[1]); w.w = cvtpk(v1[2], v1[3]); *(u32x4*)(bp + bj * 128) = w; }
                q = xsum_16_32(q);
                if (fq == 0) ssn[(size_t)row * 16 + u.pn * 4 + wc] = q; }
    }
};
template <int ACT> struct EpiRow { static constexpr bool PERM = true; bf16_t* O; int ldc; const float* ss;
    __device__ __forceinline__ void operator()(const AccT& acc, const Unit& u, int wr, int wc, int fr, int fq) const {
        const int row0 = u.pm * 256 + wr * 64 + fr, col0 = u.pn * 256 + wc * 32 + 8 * fq;
        float rsv[2][4];
        { f32x4 pv[2][4];
#pragma unroll
          for (int ai = 0; ai < 2; ++ai)
#pragma unroll
              for (int m = 0; m < 4; ++m) pv[ai][m] = *(const f32x4*)(ss + (size_t)(row0 + ai * 128 + m * 16) * 16 + fq * 4);
#pragma unroll
          for (int ai = 0; ai < 2; ++ai)
#pragma unroll
              for (int m = 0; m < 4; ++m) { const f32x4 a = pv[ai][m]; float t = (a[0] + a[1]) + (a[2] + a[3]); t = xsum_16_32(t); rsv[ai][m] = rsqrtf(t * (1.0f / DM) + EPS); } }
#pragma unroll
        for (int ai = 0; ai < 2; ++ai)
#pragma unroll
            for (int m = 0; m < 4; ++m) { const int row = row0 + ai * 128 + m * 16; const float rs = rsv[ai][m];
#pragma unroll
                for (int bj = 0; bj < 2; ++bj) { float a[8];
#pragma unroll
                    for (int n = 0; n < 2; ++n)
#pragma unroll
                        for (int j = 0; j < 4; ++j) { const float x_ = acc[ai][bj][m][n][j]; a[n * 4 + j] = ACT ? __builtin_amdgcn_rcpf(1.0f + __builtin_amdgcn_exp2f(x_ * (-rs * LOG2E))) : x_ * rs; }
                    u32x4 w; w.x = cvtpk(a[0], a[1]); w.y = cvtpk(a[2], a[3]); w.z = cvtpk(a[4], a[5]); w.w = cvtpk(a[6], a[7]);
                    *(u32x4*)(O + (size_t)row * ldc + col0 + bj * 128) = w; } }
    }
};
struct EpiGate { static constexpr bool PERM = true; bf16_t* Mg; const bf16_t* G;
    __device__ __forceinline__ void operator()(const AccT& acc, const Unit& u, int wr, int wc, int fr, int fq) const {
        const int gi = u.pn >> 2; const bool first = (gi == 0);
        const int row0 = (u.pm - gi * 257) * 256 + wr * 64 + fr, col0 = (u.pn & 3) * 256 + wc * 32 + 8 * fq;
#pragma unroll
        for (int ai = 0; ai < 2; ++ai) {
            u32x4 gv[4][2], mv[4][2];
#pragma unroll
            for (int m = 0; m < 4; ++m)
#pragma unroll
                for (int bj = 0; bj < 2; ++bj) { const int row = row0 + ai * 128 + m * 16;
                    gv[m][bj] = *(const u32x4*)(G + (size_t)row * 3072 + gi * 1024 + col0 + bj * 128);
                    mv[m][bj] = first ? (u32x4){0u, 0u, 0u, 0u} : *(const u32x4*)(Mg + (size_t)row * DM + col0 + bj * 128); }
#pragma unroll
            for (int m = 0; m < 4; ++m)
#pragma unroll
                for (int bj = 0; bj < 2; ++bj) { const int row = row0 + ai * 128 + m * 16; bf16_t* mp = Mg + (size_t)row * DM + col0 + bj * 128;
                    const u32x4 g4 = gv[m][bj], m4 = mv[m][bj]; float a[8];
                    a[0] = bflo(g4.x) * acc[ai][bj][m][0][0] + bflo(m4.x); a[1] = bfhi(g4.x) * acc[ai][bj][m][0][1] + bfhi(m4.x);
                    a[2] = bflo(g4.y) * acc[ai][bj][m][0][2] + bflo(m4.y); a[3] = bfhi(g4.y) * acc[ai][bj][m][0][3] + bfhi(m4.y);
                    a[4] = bflo(g4.z) * acc[ai][bj][m][1][0] + bflo(m4.z); a[5] = bfhi(g4.z) * acc[ai][bj][m][1][1] + bfhi(m4.z);
                    a[6] = bflo(g4.w) * acc[ai][bj][m][1][2] + bflo(m4.w); a[7] = bfhi(g4.w) * acc[ai][bj][m][1][3] + bfhi(m4.w);
                    u32x4 w; w.x = cvtpk(a[0], a[1]); w.y = cvtpk(a[2], a[3]); w.z = cvtpk(a[4], a[5]); w.w = cvtpk(a[6], a[7]);
                    *(u32x4*)mp = w; }
        }
    }
};

constexpr int MMAIN = 65536;
template <class TEpi> __device__ __forceinline__ void gemm_tail(LAS unsigned char* lds, const bf16_t* A_, const bf16_t* Bt_, int K_, const TEpi& E) {
    if (blockIdx.x >= 128) return;
    int tid = threadIdx.x; asm volatile("" : "+v"(tid));
    int K = K_; const bf16_t* A = A_; const bf16_t* Bt = Bt_; asm volatile("" : "+s"(K), "+s"(A), "+s"(Bt));
    const int lane = tid & 63, r32 = lane & 31, hi = lane >> 5; const int w = __builtin_amdgcn_readfirstlane(tid >> 6);
    const int rb = blockIdx.x >> 4, cbk = blockIdx.x & 15, row0 = MMAIN + rb * 32, col0 = cbk * 64;
    const int kchunk = K >> 3;
    const bf16_t* ap = A + (size_t)(row0 + r32) * K + w * kchunk + hi * 8;
    const bf16_t* bp0 = Bt + (size_t)(col0 + r32) * K + w * kchunk + hi * 8; const bf16_t* bp1 = bp0 + (size_t)32 * K;
    f32x16 c0, c1;
#pragma unroll
    for (int r = 0; r < 16; ++r) { c0[r] = 0.f; c1[r] = 0.f; }
    for (int k0 = 0; k0 < kchunk; k0 += 128) {
        const int nb = (kchunk - k0) >> 4; bf16x8 xa[8], w0[8], w1[8];
#pragma unroll
        for (int j = 0; j < 8; ++j) if (j < nb) { xa[j] = *(const bf16x8*)(ap + k0 + 16 * j); w0[j] = *(const bf16x8*)(bp0 + k0 + 16 * j); w1[j] = *(const bf16x8*)(bp1 + k0 + 16 * j); }
#pragma unroll
        for (int j = 0; j < 8; ++j) if (j < nb) { c0 = __builtin_amdgcn_mfma_f32_32x32x16_bf16(w0[j], xa[j], c0, 0, 0, 0); c1 = __builtin_amdgcn_mfma_f32_32x32x16_bf16(w1[j], xa[j], c1, 0, 0, 0); }
    }
    LAS float* Pp = (LAS float*)lds;
#pragma unroll
    for (int r = 0; r < 16; ++r) { Pp[((w * 2 + 0) * 16 + r) * 64 + lane] = c0[r]; Pp[((w * 2 + 1) * 16 + r) * 64 + lane] = c1[r]; }
    __syncthreads();
    const int a = w >> 2, g = w & 3; f32x4 v = {0.f, 0.f, 0.f, 0.f};
#pragma unroll
    for (int ww = 0; ww < 8; ++ww)
#pragma unroll
        for (int j = 0; j < 4; ++j) v[j] += Pp[((ww * 2 + a) * 16 + 4 * g + j) * 64 + lane];
    __syncthreads();
    E(row0 + r32, col0 + a * 32 + 8 * g + 4 * hi, v, cbk, w, lane, lds);
    __syncthreads();
}

template <class TEpi, bool SWI> __device__ __forceinline__ void gemm_tail2(LAS unsigned char* lds, const bf16_t* A_, const bf16_t* Bt_, int K_, int nitems_, const TEpi& E) {
    int tid = threadIdx.x; asm volatile("" : "+v"(tid));
    int K = K_, nitems = nitems_; const bf16_t* A = A_; const bf16_t* Bt = Bt_; asm volatile("" : "+s"(K), "+s"(A), "+s"(Bt), "+s"(nitems));
    const int lane = tid & 63, r32 = lane & 31, hi = lane >> 5; const int w = __builtin_amdgcn_readfirstlane(tid >> 6);
    const int kchunk = K >> 3;
    for (int item = blockIdx.x; item < nitems; item += gridDim.x) {
        const int rb = item & 7, cbk = item >> 3, row0 = MMAIN + rb * 32;
        const int brow0 = SWI ? (cbk >> 2) * 256 + (cbk & 3) * 32 : cbk * 64, brow1 = SWI ? brow0 + 128 : brow0 + 32;
        const bf16_t* ap = A + (size_t)(row0 + r32) * K + w * kchunk + hi * 8;
        const bf16_t* bp0 = Bt + (size_t)(brow0 + r32) * K + w * kchunk + hi * 8; const bf16_t* bp1 = Bt + (size_t)(brow1 + r32) * K + w * kchunk + hi * 8;
        f32x16 c0, c1;
#pragma unroll
        for (int r = 0; r < 16; ++r) { c0[r] = 0.f; c1[r] = 0.f; }
        for (int k0 = 0; k0 < kchunk; k0 += 128) {
            const int nb = (kchunk - k0) >> 4; bf16x8 xa[8], w0[8], w1[8];
#pragma unroll
            for (int j = 0; j < 8; ++j) if (j < nb) { xa[j] = *(const bf16x8*)(ap + k0 + 16 * j); w0[j] = *(const bf16x8*)(bp0 + k0 + 16 * j); w1[j] = *(const bf16x8*)(bp1 + k0 + 16 * j); }
#pragma unroll
            for (int j = 0; j < 8; ++j) if (j < nb) { c0 = __builtin_amdgcn_mfma_f32_32x32x16_bf16(w0[j], xa[j], c0, 0, 0, 0); c1 = __builtin_amdgcn_mfma_f32_32x32x16_bf16(w1[j], xa[j], c1, 0, 0, 0); }
        }
        LAS float* Pp = (LAS float*)lds;
#pragma unroll
        for (int r = 0; r < 16; ++r) { Pp[((w * 2 + 0) * 16 + r) * 64 + lane] = c0[r]; Pp[((w * 2 + 1) * 16 + r) * 64 + lane] = c1[r]; }
        __syncthreads();
        if (SWI) {
            if (w < 4) { f32x4 vg = {0.f, 0.f, 0.f, 0.f}, vu = {0.f, 0.f, 0.f, 0.f};
#pragma unroll
                for (int ww = 0; ww < 8; ++ww)
#pragma unroll
                    for (int j = 0; j < 4; ++j) { vg[j] += Pp[((ww * 2 + 0) * 16 + 4 * w + j) * 64 + lane]; vu[j] += Pp[((ww * 2 + 1) * 16 + 4 * w + j) * 64 + lane]; }
                E(row0 + r32, (cbk >> 2) * 128 + (cbk & 3) * 32 + 8 * w + 4 * hi, vg, vu); }
        } else {
            const int a = w >> 2, g = w & 3; f32x4 v = {0.f, 0.f, 0.f, 0.f};
#pragma unroll
            for (int ww = 0; ww < 8; ++ww)
#pragma unroll
                for (int j = 0; j < 4; ++j) v[j] += Pp[((ww * 2 + a) * 16 + 4 * g + j) * 64 + lane];
            E(row0 + r32, cbk * 64 + a * 32 + 8 * g + 4 * hi, v, v);
        }
        __syncthreads();
    }
}
template <int ACT> struct TEpiRow { bf16_t* O; int ldc; const float* ss;
    __device__ __forceinline__ void operator()(int row, int col, f32x4 v, f32x4) const { const float rs = rstd_of(ss, row);
        float a[4];
#pragma unroll
        for (int j = 0; j < 4; ++j) { const float x = v[j] * rs; a[j] = ACT ? sigm_f(x) : x; }
        u32x2 wv; wv.x = cvtpk(a[0], a[1]); wv.y = cvtpk(a[2], a[3]); *(u32x2*)(O + (size_t)row * ldc + col) = wv; }
};
struct TEpiSwi { bf16_t* O; const float* ss;
    __device__ __forceinline__ void operator()(int row, int col, f32x4 g, f32x4 u) const { const float rs = rstd_of(ss, row);
        float a[4];
#pragma unroll
        for (int j = 0; j < 4; ++j) a[j] = silu_f(g[j] * rs) * (u[j] * rs);
        u32x2 wv; wv.x = cvtpk(a[0], a[1]); wv.y = cvtpk(a[2], a[3]); *(u32x2*)(O + (size_t)row * DFF + col) = wv; }
};
struct TEpiRes { bf16_t* hb; float* ssn; float c;
    __device__ __forceinline__ void operator()(int row, int col, f32x4 v, int cbk, int w, int lane, LAS unsigned char* lds) const {
        bf16_t* bp = hb + (size_t)row * DM + col; const u32x2 h2 = *(const u32x2*)bp;
        f32x4 hv = {bflo(h2.x), bfhi(h2.x), bflo(h2.y), bfhi(h2.y)}; hv = hv + v * c;
        u32x2 wv; wv.x = cvtpk(hv[0], hv[1]); wv.y = cvtpk(hv[2], hv[3]); *(u32x2*)bp = wv;
        float q = (hv[0] * hv[0] + hv[1] * hv[1]) + (hv[2] * hv[2] + hv[3] * hv[3]); q += __shfl_xor(q, 32);
        LAS float* qb = (LAS float*)lds;
        if (lane < 32) qb[w * 32 + lane] = q;
        __syncthreads();
        if (w == 0 && lane < 32) { float t = 0.f;
#pragma unroll
            for (int ww = 0; ww < 8; ++ww) t += qb[ww * 32 + lane];
            ssn[(size_t)row * 16 + cbk] = t; }
    }
};
struct TEpiGate { bf16_t* Mg; const bf16_t* G; int gi; int first;
    __device__ __forceinline__ void operator()(int row, int col, f32x4 v, int cbk, int w, int lane, LAS unsigned char* lds) const {
        const u32x2 gv = *(const u32x2*)(G + (size_t)row * 3072 + gi * 1024 + col); bf16_t* mp = Mg + (size_t)row * DM + col;
        float a0 = bflo(gv.x) * v[0], a1 = bfhi(gv.x) * v[1], a2 = bflo(gv.y) * v[2], a3 = bfhi(gv.y) * v[3];
        if (!first) { const u32x2 mv = *(const u32x2*)mp; a0 += bflo(mv.x); a1 += bfhi(mv.x); a2 += bflo(mv.y); a3 += bfhi(mv.y); }
        u32x2 wv; wv.x = cvtpk(a0, a1); wv.y = cvtpk(a2, a3); *(u32x2*)mp = wv;
    }
};

constexpr int APITCH = 144, ASLOT = 64 * APITCH;
__device__ __forceinline__ int crow(int r, int hi) { return (r & 3) + 8 * (r >> 2) + 4 * hi; }
__device__ __forceinline__ s16x4 vtr(const LAS char* p) { return __builtin_bit_cast(s16x4, __builtin_amdgcn_ds_read_tr16_b64_v4i16((LAS s16x4*)p)); }
__device__ __forceinline__ int t5_bucket(int rel) {
    const int n = rel < 0 ? -rel : rel; int idx;
    if (n < 8) idx = n; else idx = 8 + (n >= 12) + (n >= 16) + (n >= 23) + (n >= 32) + (n >= 46) + (n >= 64) + (n >= 91);
    return idx + (rel > 0 ? 16 : 0);
}
__device__ __forceinline__ u32x4 pair16(u32x2 we, u32x2 wo) {
    const auto rx = __builtin_amdgcn_permlane32_swap(wo.x, we.x, false, false); const auto ry = __builtin_amdgcn_permlane32_swap(wo.y, we.y, false, false);
    return (u32x4){rx[0], ry[0], rx[1], ry[1]};
}
struct AttnP {
    const bf16_t* proj; bf16_t* ya; bf16_t* yb; bf16_t* yc;
    const float* t5; const float* rpb; const float* sink; const float* subg; const float* lq1; const float* lk1; const float* lq2; const float* lk2; int layer;
};
__device__ __forceinline__ float lam_init_of(int l) { return l == 0 ? 0.2f : l == 1 ? 0.355509068f : l == 2 ? 0.470713018f : 0.556058204f; }
template <int MODE> struct ACfg;
template <> struct ACfg<0> { static constexpr int NS = 4, ND = 4; };
template <> struct ACfg<1> { static constexpr int NS = 8, ND = 2; };
template <> struct ACfg<2> { static constexpr int NS = 2, ND = 2; };

template <int MODE> __device__ __forceinline__ void attn_unit(const AttnP& P, int u, LAS char* lds, bool fill) {
    constexpr int NS = ACfg<MODE>::NS, ND = ACfg<MODE>::ND;
    int tid = threadIdx.x; asm volatile("" : "+v"(tid));
    const int lane = tid & 63, r32 = lane & 31, hi = lane >> 5; const int w = __builtin_amdgcn_readfirstlane(tid >> 6);
    int b, x1, x2;
    if (MODE == 0) { b = u / (4 * 33); x1 = (u / 33) & 3; x2 = u % 33; }
    else { x1 = u / (NBATCH * 65); b = (u / 65) % NBATCH; x2 = u % 65; }
    int qtok0, qcol, kslot, head; bool metaunit = false;
    if (MODE == 0) { const int qs = w >> 1, mp = w & 1; head = x1; qtok0 = x2 * 128 + qs * 32; qcol = x1 * 128 + mp * 64; kslot = mp; }
    else if (MODE == 1) { const int hh = w >> 1, qs = w & 1; head = x1 * 4 + hh; metaunit = (x2 == 64); qtok0 = metaunit ? qs * 32 : NMETA + 64 * x2 + qs * 32; qcol = 1536 + head * 64; kslot = 2 * hh; }
    else { const int g = w >> 1, qs = w & 1; head = x1 * 4 + g; qtok0 = x2 * 64 + qs * 32; qcol = 3072 + head * 64; kslot = 0; }
    const int tq = qtok0 + r32;
    int nt, rs_ = 0, lo_ = 0;
    if (MODE == 0) nt = 65;
    else if (MODE == 1) { const int r = metaunit ? 0 : x2; rs_ = r - 4; rs_ = rs_ < 0 ? 0 : (rs_ > 56 ? 56 : rs_); nt = 9; }
    else { const int q0 = x2 * 64; lo_ = q0 - 128; if (lo_ < 0) lo_ = 0; int hiq = q0 + 192; if (hiq > LT) hiq = LT; nt = (hiq - lo_ + 63) / 64 + (lo_ > 0 ? 1 : 0); }
#define TILE_TOK0(t) (MODE == 0 ? 64 * (t) : MODE == 1 ? ((t) == 0 ? 0 : NMETA + 64 * (rs_ + (t) - 1)) : (lo_ > 0 ? ((t) == 0 ? 0 : lo_ + 64 * ((t) - 1)) : 64 * (t)))
#define STREAM_COL(s) (MODE == 0 ? ((s) < 2 ? 512 + x1 * 128 + (s) * 64 : 1024 + x1 * 128 + ((s) - 2) * 64) : MODE == 1 ? (((s) & 1) ? 2560 : 2048) + (x1 * 4 + ((s) >> 1)) * 64 : ((s) == 0 ? 3584 + x1 * 64 : 3712 + x1 * 64))
    LAS float* tab = (LAS float*)(lds + (MODE == 1 ? 98304 : MODE == 2 ? 110592 : NS * ASLOT));
    if (!fill) {} else
    if (MODE == 0) { for (int i = tid; i < 257; i += 512) tab[i] = P.t5[t5_bucket(i - 128) * 12 + x1] * LOG2E; }
    else if (MODE == 2) { for (int i = tid; i < 4 * 257; i += 512) { const int g = i / 257, j = i - g * 257; tab[i] = P.t5[t5_bucket(j - 128) * 12 + 4 + x1 * 4 + g] * LOG2E; }
        for (int i = tid; i < 4 * 384; i += 512) { const int g = i / 384, rel = i - g * 384 - 191; tab[4 * 257 + i] = (rel >= -128 && rel <= 128) ? P.t5[t5_bucket(rel) * 12 + 4 + x1 * 4 + g] * LOG2E : NEGV; } }
    else {
        for (int i = tid; i < 4 * 593 + 128; i += 512) { const int hh = i / 593, j = i - hh * 593 - 64; tab[i] = (i < 4 * 593 && j >= 0 && j < 465) ? P.rpb[(x1 * 4 + hh) * 465 + j] * LOG2E : 0.f; } }
    const LAS float* mytab = MODE == 0 ? tab : MODE == 2 ? tab + (w >> 1) * 257 : tab + (w >> 1) * 593 + 64;
    const LAS float* mytab2 = tab + 4 * 257 + (w >> 1) * 384;
    bf16x8 qr[4];
    { int qt = tq > LT - 1 ? LT - 1 : tq; const bf16_t* qp = P.proj + (size_t)(b * LT + qt) * INC + qcol + hi * 8;
#pragma unroll
      for (int ds = 0; ds < 4; ++ds) qr[ds] = *(const bf16x8*)(qp + ds * 16); }
    float mrun = NEGV, lrun = 0.f; f32x16 o[ND];
#pragma unroll
    for (int d = 0; d < ND; ++d)
#pragma unroll
        for (int r = 0; r < 16; ++r) o[d][r] = 0.f;
    const int lrow = tid >> 3, lch = tid & 7;
    u32x4 pre[NS];
    const bf16_t* pb = P.proj + (size_t)b * LT * INC + lch * 8;
#define ISSUE(t) do { int tok_ = TILE_TOK0(t) + lrow; tok_ = tok_ > LT - 1 ? LT - 1 : tok_; const bf16_t* src_ = pb + (size_t)tok_ * INC; \
        _Pragma("unroll") for (int s = 0; s < NS; ++s) pre[s] = *(const u32x4*)(src_ + STREAM_COL(s)); } while (0)
    ISSUE(0);
    int ccol = 0, cstart = 0;
    if (MODE == 1 && !metaunit) { ccol = (tq - NMETA) & 63; cstart = ccol - 8; cstart = cstart < 0 ? 0 : (cstart > 48 ? 48 : cstart); }
    float ng0[16], ng1[16];
    if (MODE == 1) {
#pragma unroll
        for (int r = 0; r < 16; ++r) { const int k0 = crow(r, hi), k1 = k0 + 32; ng0[r] = (k0 >= cstart && k0 < cstart + 16) ? 0.f : NEGV; ng1[r] = (k1 >= cstart && k1 < cstart + 16) ? 0.f : NEGV; }
    }
    const LAS char* kb = lds + kslot * ASLOT + r32 * APITCH + hi * 16;
    const int vrow = 4 * hi + ((lane & 15) >> 2), vcolb = 32 * ((lane >> 4) & 1) + 8 * (lane & 3);
    for (int t = 0; t < nt; ++t) {
        __syncthreads();
#pragma unroll
        for (int s = 0; s < NS; ++s) *(LAS u32x4*)(lds + s * ASLOT + lrow * APITCH + lch * 16) = pre[s];
        __syncthreads();
        if (t + 1 < nt) ISSUE(t + 1);
        const int tok0 = TILE_TOK0(t);
        f32x16 p0, p1;
#pragma unroll
        for (int r = 0; r < 16; ++r) { p0[r] = 0.f; p1[r] = 0.f; }
#pragma unroll
        for (int ds = 0; ds < 4; ++ds) {
            const bf16x8 k0 = *(const LAS bf16x8*)(kb + ds * 32);
            const bf16x8 k1 = *(const LAS bf16x8*)(kb + 32 * APITCH + ds * 32);
            p0 = __builtin_amdgcn_mfma_f32_32x32x16_bf16(k0, qr[ds], p0, 0, 0, 0);
            p1 = __builtin_amdgcn_mfma_f32_32x32x16_bf16(k1, qr[ds], p1, 0, 0, 0);
        }
        if (MODE == 0) {
            const bool farl = (tok0 + 63 + 128 <= qtok0), farr = (tok0 - (qtok0 + 31) >= 128) && (tok0 + 64 <= LT);
            if (farl || farr) { const float cb = farl ? mytab[0] : mytab[256];
#pragma unroll
                for (int r = 0; r < 16; ++r) { p0[r] += cb; p1[r] += cb; } }
            else {
#pragma unroll
                for (int r = 0; r < 16; ++r) { const int tk0 = tok0 + crow(r, hi), tk1 = tk0 + 32;
                    int i0 = tk0 - tq + 128; i0 = i0 < 0 ? 0 : (i0 > 256 ? 256 : i0); int i1 = tk1 - tq + 128; i1 = i1 < 0 ? 0 : (i1 > 256 ? 256 : i1);
                    p0[r] = tk0 < LT ? p0[r] + mytab[i0] : NEGV; p1[r] = tk1 < LT ? p1[r] + mytab[i1] : NEGV; } }
        } else if (MODE == 2) {
          if (tok0 >= NMETA && tok0 + 64 <= LT) {
            const LAS float* t2 = mytab2 + (tok0 - tq + 191 + 4 * hi);
#pragma unroll
            for (int r = 0; r < 16; ++r) { p0[r] += t2[(r & 3) + 8 * (r >> 2)]; p1[r] += t2[(r & 3) + 8 * (r >> 2) + 32]; }
          } else
#pragma unroll
            for (int r = 0; r < 16; ++r) { const int tk0 = tok0 + crow(r, hi), tk1 = tk0 + 32; const int r0 = tk0 - tq, r1 = tk1 - tq;
                int i0 = r0 + 128; i0 = i0 < 0 ? 0 : (i0 > 256 ? 256 : i0); int i1 = r1 + 128; i1 = i1 < 0 ? 0 : (i1 > 256 ? 256 : i1);
                const bool v0 = (tk0 < NMETA || (r0 >= -128 && r0 <= 128)) && tk0 < LT, v1 = (tk1 < NMETA || (r1 >= -128 && r1 <= 128)) && tk1 < LT;
                p0[r] = v0 ? p0[r] + mytab[i0] : NEGV; p1[r] = v1 ? p1[r] + mytab[i1] : NEGV; }
        } else {
            if (t == 0) {
#pragma unroll
                for (int r = 0; r < 16; ++r) { const int k0 = crow(r, hi); p0[r] = k0 < NMETA ? p0[r] : NEGV; p1[r] = NEGV; }
            } else {
                const int roff = (rs_ + t - 1) - x2 + 7;
                const LAS float* rt = metaunit ? tab + 4 * 593 + 4 * hi : mytab + roff * 31 + 15 - ccol + 4 * hi;
#pragma unroll
                for (int r = 0; r < 16; ++r) { p0[r] = p0[r] + rt[(r & 3) + 8 * (r >> 2)] + ng0[r]; p1[r] = p1[r] + rt[(r & 3) + 8 * (r >> 2) + 32] + ng1[r]; }
            }
        }
        float mx = p0[0];
#pragma unroll
        for (int r = 1; r < 16; ++r) mx = fmaxf(mx, p0[r]);
#pragma unroll
        for (int r = 0; r < 16; ++r) mx = fmaxf(mx, p1[r]);
        { const auto rr = __builtin_amdgcn_permlane32_swap(__float_as_uint(mx), __float_as_uint(mx), false, false); mx = fmaxf(__uint_as_float(rr[0]), __uint_as_float(rr[1])); }
        if (__any(mx > mrun + 8.0f)) {
            const float mnew = fmaxf(mrun, mx); const float f = __builtin_amdgcn_exp2f(mrun - mnew); mrun = mnew; lrun *= f;
#pragma unroll
            for (int d = 0; d < ND; ++d)
#pragma unroll
                for (int r = 0; r < 16; ++r) o[d][r] *= f;
        }
        float sacc = 0.f;
#pragma unroll
        for (int r = 0; r < 16; ++r) { p0[r] = __builtin_amdgcn_exp2f(p0[r] - mrun); p1[r] = __builtin_amdgcn_exp2f(p1[r] - mrun); sacc += p0[r] + p1[r]; }
        lrun += sacc;
        bf16x8 pf[4];
        { u32x4 a;
          a.x = cvtpk(p0[0], p0[1]); a.y = cvtpk(p0[2], p0[3]); a.z = cvtpk(p0[4], p0[5]); a.w = cvtpk(p0[6], p0[7]); pf[0] = __builtin_bit_cast(bf16x8, a);
          a.x = cvtpk(p0[8], p0[9]); a.y = cvtpk(p0[10], p0[11]); a.z = cvtpk(p0[12], p0[13]); a.w = cvtpk(p0[14], p0[15]); pf[1] = __builtin_bit_cast(bf16x8, a);
          a.x = cvtpk(p1[0], p1[1]); a.y = cvtpk(p1[2], p1[3]); a.z = cvtpk(p1[4], p1[5]); a.w = cvtpk(p1[6], p1[7]); pf[2] = __builtin_bit_cast(bf16x8, a);
          a.x = cvtpk(p1[8], p1[9]); a.y = cvtpk(p1[10], p1[11]); a.z = cvtpk(p1[12], p1[13]); a.w = cvtpk(p1[14], p1[15]); pf[3] = __builtin_bit_cast(bf16x8, a); }
#pragma unroll
        for (int d = 0; d < ND; ++d) {
            const int vslot = MODE == 0 ? 2 + (d >> 1) : MODE == 1 ? kslot + 1 : 1;
            const LAS char* vb = lds + vslot * ASLOT + vrow * APITCH + (d & 1) * 64 + vcolb;
#pragma unroll
            for (int ks = 0; ks < 4; ++ks) {
                const s16x4 vl = vtr(vb + (16 * ks) * APITCH), vh = vtr(vb + (16 * ks + 8) * APITCH);
                const bf16x8 vf = (bf16x8){vl[0], vl[1], vl[2], vl[3], vh[0], vh[1], vh[2], vh[3]};
                o[d] = __builtin_amdgcn_mfma_f32_32x32x16_bf16(vf, pf[ks], o[d], 0, 0, 0);
            }
        }
    }
    float ltot = lrun + __shfl_xor(lrun, 32);
    if (MODE == 2) ltot += __builtin_amdgcn_exp2f(P.sink[head] * LOG2E - mrun);
    const float inv = 1.0f / ltot;
    if (MODE == 0) {
        float a1 = P.lq1[lane] * P.lk1[lane], a2 = P.lq2[lane] * P.lk2[lane];
#pragma unroll
        for (int s = 1; s < 64; s <<= 1) { a1 += __shfl_xor(a1, s); a2 += __shfl_xor(a2, s); }
        const float lam = __expf(a1) - __expf(a2) + lam_init_of(P.layer);
        __syncthreads();
        LAS float* X = (LAS float*)lds;
        const int qs = w >> 1, mp = w & 1;
        if (mp == 1) {
#pragma unroll
            for (int d = 0; d < ND; ++d)
#pragma unroll
                for (int r = 0; r < 16; ++r) X[(qs * 128 + d * 32 + crow(r, hi)) * 32 + r32] = o[d][r] * inv;
        }
        __syncthreads();
        if (mp == 0) {
            float q = 0.f;
#pragma unroll
            for (int d = 0; d < ND; ++d)
#pragma unroll
                for (int r = 0; r < 16; ++r) { const float v = o[d][r] * inv - lam * X[(qs * 128 + d * 32 + crow(r, hi)) * 32 + r32]; o[d][r] = v; q += v * v; }
            q += __shfl_xor(q, 32);
            const float rn = rsqrtf(q * (1.0f / 128.0f) + EPS) * (1.0f - lam_init_of(P.layer));
            if (tq < LT) {
                bf16_t* op = P.ya + (size_t)(b * LT + tq) * 512 + x1 * 128;
#pragma unroll
                for (int d = 0; d < ND; ++d)
#pragma unroll
                    for (int r4 = 0; r4 < 4; ++r4) { const int dd = d * 32 + 8 * r4 + 4 * hi; const f32x4 gg = *(const f32x4*)(P.subg + dd);
                        u32x2 wv; wv.x = cvtpk(o[d][4 * r4] * rn * gg[0], o[d][4 * r4 + 1] * rn * gg[1]); wv.y = cvtpk(o[d][4 * r4 + 2] * rn * gg[2], o[d][4 * r4 + 3] * rn * gg[3]);
                        *(u32x2*)(op + dd) = wv; }
            }
        }
    } else {
        const bool qvalid = MODE == 1 ? (metaunit ? tq < NMETA : true) : (tq < LT);
        bf16_t* op = (MODE == 1 ? P.yb : P.yc) + (size_t)(b * LT + tq) * 512 + head * 64;
#pragma unroll
        for (int d = 0; d < ND; ++d)
#pragma unroll
            for (int rp = 0; rp < 2; ++rp) { u32x2 we, wo;
                we.x = cvtpk(o[d][8 * rp] * inv, o[d][8 * rp + 1] * inv); we.y = cvtpk(o[d][8 * rp + 2] * inv, o[d][8 * rp + 3] * inv);
                wo.x = cvtpk(o[d][8 * rp + 4] * inv, o[d][8 * rp + 5] * inv); wo.y = cvtpk(o[d][8 * rp + 6] * inv, o[d][8 * rp + 7] * inv);
                const u32x4 v = pair16(we, wo);
                if (qvalid) *(u32x4*)(op + d * 32 + 8 * (2 * rp + (hi ? 0 : 1))) = v; }
    }
    __syncthreads();
#undef TILE_TOK0
#undef STREAM_COL
#undef ISSUE
}

constexpr int AKP = 144, AVP = 192, AKS = 64 * AKP, AVS = 64 * AVP, ABUF = 2 * AKS + 2 * AVS, ATAB = 3 * ABUF;
__device__ __forceinline__ void attn_unit_A(const AttnP& P, int u, LAS char* lds) {
    int tid = threadIdx.x; asm volatile("" : "+v"(tid));
    const int lane = tid & 63, r32 = lane & 31, hi = lane >> 5; const int w = __builtin_amdgcn_readfirstlane(tid >> 6);
    const int b = u / (4 * 33), h = (u / 33) & 3, qb = u % 33;
    const int qs = w >> 1, mp = w & 1;
    const int qtok0 = qb * 128 + qs * 32, tq = qtok0 + r32;
    constexpr int nt = 65;
    LAS float* tab = (LAS float*)(lds + ATAB);
    for (int i = tid; i < 257; i += 512) tab[i] = P.t5[t5_bucket(i - 128) * 12 + h] * LOG2E;
    bf16x8 qr[4];
    { const int qt = tq > LT - 1 ? LT - 1 : tq; const bf16_t* qp = P.proj + (size_t)(b * LT + qt) * INC + h * 128 + mp * 64 + hi * 8;
#pragma unroll
      for (int ds = 0; ds < 4; ++ds) qr[ds] = *(const bf16x8*)(qp + ds * 16); }
    f32x16 o[4];
#pragma unroll
    for (int d = 0; d < 4; ++d)
#pragma unroll
        for (int r = 0; r < 16; ++r) o[d][r] = 0.f;
    const int lrow = tid >> 3, lch = tid & 7;
    u32x4 pre[4];
    const bf16_t* pb = P.proj + (size_t)b * LT * INC + lch * 8 + h * 128;
#define A_ISSUE(t) do { int tok_ = 64 * (t) + lrow; tok_ = tok_ > LT - 1 ? LT - 1 : tok_; const bf16_t* src_ = pb + (size_t)tok_ * INC; \
        pre[0] = *(const u32x4*)(src_ + 512); pre[1] = *(const u32x4*)(src_ + 576); pre[2] = *(const u32x4*)(src_ + 1024); pre[3] = *(const u32x4*)(src_ + 1088); } while (0)
#define A_WRITE(bufo) do { LAS char* d_ = lds + (bufo); \
        *(LAS u32x4*)(d_ + lrow * AKP + lch * 16) = pre[0]; *(LAS u32x4*)(d_ + AKS + lrow * AKP + lch * 16) = pre[1]; \
        *(LAS u32x4*)(d_ + 2 * AKS + lrow * AVP + lch * 16) = pre[2]; *(LAS u32x4*)(d_ + 2 * AKS + AVS + lrow * AVP + lch * 16) = pre[3]; } while (0)
#define A_BAR() asm volatile("s_waitcnt lgkmcnt(0)\n\ts_barrier" ::: "memory")
#define A_QK(S0, S1, bufo) do { const LAS char* kb_ = lds + (bufo) + mp * AKS + r32 * AKP + hi * 16; \
        _Pragma("unroll") for (int r = 0; r < 16; ++r) { S0[r] = 0.f; S1[r] = 0.f; } \
        _Pragma("unroll") for (int ds = 0; ds < 4; ++ds) { const bf16x8 k0_ = *(const LAS bf16x8*)(kb_ + ds * 32); const bf16x8 k1_ = *(const LAS bf16x8*)(kb_ + 32 * AKP + ds * 32); \
            S0 = __builtin_amdgcn_mfma_f32_32x32x16_bf16(k0_, qr[ds], S0, 0, 0, 0); S1 = __builtin_amdgcn_mfma_f32_32x32x16_bf16(k1_, qr[ds], S1, 0, 0, 0); } } while (0)
#define A_BIAS(S0, S1, t, cb) do { const int tok0_ = 64 * (t); \
        const bool farl_ = (tok0_ + 63 + 128 <= qtok0), farr_ = (tok0_ - (qtok0 + 31) >= 128) && (tok0_ + 64 <= LT); \
        if (farl_ || farr_) { cb = farl_ ? tab[0] : tab[256]; } \
        else { cb = 0.f; \
            _Pragma("unroll") for (int r = 0; r < 16; ++r) { const int tk0 = tok0_ + crow(r, hi), tk1 = tk0 + 32; \
                int i0 = tk0 - tq + 128; i0 = i0 < 0 ? 0 : (i0 > 256 ? 256 : i0); int i1 = tk1 - tq + 128; i1 = i1 < 0 ? 0 : (i1 > 256 ? 256 : i1); \
                S0[r] = tk0 < LT ? S0[r] + tab[i0] : NEGV; S1[r] = tk1 < LT ? S1[r] + tab[i1] : NEGV; } } \
        float mx_ = fmaxf(fmaxf(S0[0], S0[1]), S1[0]); \
        _Pragma("unroll") for (int r = 2; r < 16; r += 2) mx_ = fmaxf(fmaxf(mx_, S0[r]), S0[r + 1]); \
        _Pragma("unroll") for (int r = 1; r < 15; r += 2) mx_ = fmaxf(fmaxf(mx_, S1[r]), S1[r + 1]); \
        mx_ = fmaxf(mx_, S1[15]) + cb; mx_ = fmaxf(mx_, __shfl_xor(mx_, 32)); \
        if (__any(mx_ > mrun + 8.0f)) { const float mnew_ = fmaxf(mrun, mx_); const float f_ = __builtin_amdgcn_exp2f(mrun - mnew_); mrun = mnew_; lrun *= f_; \
            _Pragma("unroll") for (int d = 0; d < 4; ++d) _Pragma("unroll") for (int r = 0; r < 16; ++r) o[d][r] *= f_; } } while (0)
    float a1 = P.lq1[lane] * P.lk1[lane], a2 = P.lq2[lane] * P.lk2[lane];
#pragma unroll
    for (int s = 1; s < 64; s <<= 1) { a1 += __shfl_xor(a1, s); a2 += __shfl_xor(a2, s); }
    unsigned lamu = __builtin_amdgcn_readfirstlane(__float_as_uint(__expf(a1) - __expf(a2) + lam_init_of(P.layer))); asm volatile("" : "+s"(lamu));
    const float lam = __uint_as_float(lamu);
    A_ISSUE(0);
    __syncthreads();
    A_WRITE(0); A_ISSUE(1);
    A_BAR();
    f32x16 sa0, sa1, negc; float lrun = 0.f;
    const int vrow = 4 * hi + ((lane & 15) >> 2), vcolb = 32 * ((lane >> 4) & 1) + 8 * (lane & 3);
    int clsk;
#define A_CLS(t) (((64 * (t)) + 63 + 128 <= qtok0) ? 0 : ((((64 * (t)) - (qtok0 + 31) >= 128) && ((64 * (t)) + 64 <= LT)) ? 2 : 1))
#define A_CVAL(c) ((c) == 0 ? tab[0] : (c) == 2 ? tab[256] : 0.f)
#define A_NEAR(S0, S1, t) do { const int tok0_ = 64 * (t); \
        _Pragma("unroll") for (int r = 0; r < 16; ++r) { const int tk0 = tok0_ + crow(r, hi), tk1 = tk0 + 32; \
            int i0 = tk0 - tq + 128; i0 = i0 < 0 ? 0 : (i0 > 256 ? 256 : i0); int i1 = tk1 - tq + 128; i1 = i1 < 0 ? 0 : (i1 > 256 ? 256 : i1); \
            S0[r] = tk0 < LT ? S0[r] + tab[i0] : NEGV; S1[r] = tk1 < LT ? S1[r] + tab[i1] : NEGV; } } while (0)
#define A_ROWMAX(S0, S1, mx_) do { mx_ = fmaxf(fmaxf(S0[0], S0[1]), S1[0]); \
        _Pragma("unroll") for (int r = 2; r < 16; r += 2) mx_ = fmaxf(fmaxf(mx_, S0[r]), S0[r + 1]); \
        _Pragma("unroll") for (int r = 1; r < 15; r += 2) mx_ = fmaxf(fmaxf(mx_, S1[r]), S1[r + 1]); \
        mx_ = fmaxf(mx_, S1[15]); { const auto rr_ = __builtin_amdgcn_permlane32_swap(__float_as_uint(mx_), __float_as_uint(mx_), false, false); mx_ = fmaxf(__uint_as_float(rr_[0]), __uint_as_float(rr_[1])); } } while (0)
    {
        A_QK(sa0, sa1, 0);
        clsk = A_CLS(0);
        if (clsk == 1) A_NEAR(sa0, sa1, 0);
        else { const float c0 = A_CVAL(clsk);
#pragma unroll
            for (int r = 0; r < 16; ++r) { sa0[r] += c0; sa1[r] += c0; } }
        float mx0; A_ROWMAX(sa0, sa1, mx0);
        const float nc = A_CVAL(clsk) - mx0;
#pragma unroll
        for (int r = 0; r < 16; ++r) { sa0[r] -= mx0; sa1[r] -= mx0; negc[r] = nc; }
    }
    int bcur = 0, bnext = ABUF;
    for (int t = 0; t < nt; ++t) {
        const bool more = (t + 1 < nt);
        if (more) { A_WRITE(bnext); if (t + 2 < nt) A_ISSUE(t + 2); }
        int clsn = clsk;
        if (more) { clsn = A_CLS(t + 1);
            if (clsn != clsk) { const float dc = A_CVAL(clsn) - A_CVAL(clsk); clsk = clsn;
#pragma unroll
                for (int r = 0; r < 16; ++r) negc[r] += dc; } }
#define A_QKBLK() do { const LAS char* kb_ = lds + bnext + mp * AKS + r32 * AKP + hi * 16; bf16x8 kf[8]; \
        _Pragma("unroll") for (int ds = 0; ds < 4; ++ds) { kf[2 * ds] = *(const LAS bf16x8*)(kb_ + ds * 32); kf[2 * ds + 1] = *(const LAS bf16x8*)(kb_ + 32 * AKP + ds * 32); } \
        sa0 = __builtin_amdgcn_mfma_f32_32x32x16_bf16(kf[0], qr[0], negc, 0, 0, 0); sa1 = __builtin_amdgcn_mfma_f32_32x32x16_bf16(kf[1], qr[0], negc, 0, 0, 0); \
        _Pragma("unroll") for (int ds = 1; ds < 4; ++ds) { sa0 = __builtin_amdgcn_mfma_f32_32x32x16_bf16(kf[2 * ds], qr[ds], sa0, 0, 0, 0); sa1 = __builtin_amdgcn_mfma_f32_32x32x16_bf16(kf[2 * ds + 1], qr[ds], sa1, 0, 0, 0); } } while (0)
        const LAS char* vbase = lds + bcur + 2 * AKS + vrow * AVP + vcolb;
#define A_VLOAD(dst, d) do { const LAS char* vb_ = vbase + ((d) >> 1) * AVS + ((d) & 1) * 64; \
        _Pragma("unroll") for (int ks = 0; ks < 4; ++ks) { const s16x4 vl_ = vtr(vb_ + (16 * ks) * AVP), vh_ = vtr(vb_ + (16 * ks + 8) * AVP); \
            dst[ks] = (bf16x8){vl_[0], vl_[1], vl_[2], vl_[3], vh_[0], vh_[1], vh_[2], vh_[3]}; } } while (0)
#define A_VMMA(src, d) do { _Pragma("unroll") for (int ks = 0; ks < 4; ++ks) o[d] = __builtin_amdgcn_mfma_f32_32x32x16_bf16(src[ks], pf[ks], o[d], 0, 0, 0); } while (0)
        bf16x8 vfa[4], vfb[4];
        A_VLOAD(vfa, 0);
        __builtin_amdgcn_sched_barrier(0);
        float sacc = 0.f;
#pragma unroll
        for (int r = 0; r < 16; ++r) { sa0[r] = __builtin_amdgcn_exp2f(sa0[r]); sa1[r] = __builtin_amdgcn_exp2f(sa1[r]); sacc += sa0[r] + sa1[r]; }
        lrun += sacc;
        bf16x8 pf[4];
        { u32x4 a;
          a.x = cvtpk(sa0[0], sa0[1]); a.y = cvtpk(sa0[2], sa0[3]); a.z = cvtpk(sa0[4], sa0[5]); a.w = cvtpk(sa0[6], sa0[7]); pf[0] = __builtin_bit_cast(bf16x8, a);
          a.x = cvtpk(sa0[8], sa0[9]); a.y = cvtpk(sa0[10], sa0[11]); a.z = cvtpk(sa0[12], sa0[13]); a.w = cvtpk(sa0[14], sa0[15]); pf[1] = __builtin_bit_cast(bf16x8, a);
          a.x = cvtpk(sa1[0], sa1[1]); a.y = cvtpk(sa1[2], sa1[3]); a.z = cvtpk(sa1[4], sa1[5]); a.w = cvtpk(sa1[6], sa1[7]); pf[2] = __builtin_bit_cast(bf16x8, a);
          a.x = cvtpk(sa1[8], sa1[9]); a.y = cvtpk(sa1[10], sa1[11]); a.z = cvtpk(sa1[12], sa1[13]); a.w = cvtpk(sa1[14], sa1[15]); pf[3] = __builtin_bit_cast(bf16x8, a); }
        __builtin_amdgcn_sched_barrier(0);
        A_VLOAD(vfb, 1);
        __builtin_amdgcn_sched_barrier(0);
        A_VMMA(vfa, 0);
        A_VLOAD(vfa, 2);
        __builtin_amdgcn_sched_barrier(0);
        A_VMMA(vfb, 1);
        A_VLOAD(vfb, 3);
        __builtin_amdgcn_sched_barrier(0);
        A_VMMA(vfa, 2);
        __builtin_amdgcn_sched_barrier(0);
        A_VMMA(vfb, 3);
#undef A_VLOAD
#undef A_VMMA
        __builtin_amdgcn_sched_barrier(0); A_BAR(); A_QKBLK();
#undef A_QKBLK
        if (more) {
            if (clsn == 1) A_NEAR(sa0, sa1, t + 1);
            float mx_; A_ROWMAX(sa0, sa1, mx_);
            if (__any(mx_ > 8.0f)) { const float dl = fmaxf(mx_, 0.f); const float f_ = __builtin_amdgcn_exp2f(-dl); lrun *= f_;
#pragma unroll
                for (int r = 0; r < 16; ++r) { sa0[r] -= dl; sa1[r] -= dl; negc[r] -= dl; }
#pragma unroll
                for (int d = 0; d < 4; ++d)
#pragma unroll
                    for (int r = 0; r < 16; ++r) o[d][r] *= f_; }
        }
        bcur = bnext; bnext = bnext + ABUF; if (bnext == 3 * ABUF) bnext = 0;
    }
#undef A_CLS
#undef A_CVAL
#undef A_NEAR
#undef A_ROWMAX
    const float inv = 1.0f / (lrun + __shfl_xor(lrun, 32));
    __syncthreads();
    LAS float* X = (LAS float*)lds;
    if (mp == 1) {
#pragma unroll
        for (int d = 0; d < 4; ++d)
#pragma unroll
            for (int r = 0; r < 16; ++r) X[(qs * 128 + d * 32 + crow(r, hi)) * 32 + r32] = o[d][r] * inv;
    }
    __syncthreads();
    if (mp == 0) {
        float q = 0.f;
#pragma unroll
        for (int d = 0; d < 4; ++d)
#pragma unroll
            for (int r = 0; r < 16; ++r) { const float v = o[d][r] * inv - lam * X[(qs * 128 + d * 32 + crow(r, hi)) * 32 + r32]; o[d][r] = v; q += v * v; }
        q += __shfl_xor(q, 32);
        int ly = P.layer; asm volatile("" : "+s"(ly));
        const float rn = rsqrtf(q * (1.0f / 128.0f) + EPS) * (1.0f - lam_init_of(ly));
        { bf16_t* op = P.ya + (size_t)(b * LT + tq) * 512 + h * 128; const bool qok = tq < LT;
#pragma unroll
            for (int d = 0; d < 4; ++d)
#pragma unroll
                for (int rp = 0; rp < 2; ++rp) { u32x2 w2[2];
#pragma unroll
                    for (int k = 0; k < 2; ++k) { const int r4 = 2 * rp + k, dd = d * 32 + 8 * r4 + 4 * hi; const f32x4 gg = *(const f32x4*)(P.subg + dd);
                        w2[k].x = cvtpk(o[d][4 * r4] * rn * gg[0], o[d][4 * r4 + 1] * rn * gg[1]); w2[k].y = cvtpk(o[d][4 * r4 + 2] * rn * gg[2], o[d][4 * r4 + 3] * rn * gg[3]); }
                    const u32x4 v = pair16(w2[0], w2[1]);
                    if (qok) *(u32x4*)(op + d * 32 + 8 * (2 * rp + (hi ? 0 : 1))) = v; }
        }
    }
    __syncthreads();
#undef A_ISSUE
#undef A_WRITE
#undef A_BAR
#undef A_QK
#undef A_BIAS
}
constexpr int NUA = NBATCH * 4 * 33, NUB = NBATCH * 2 * 65, NUC = NBATCH * 2 * 65;

__device__ __forceinline__ void conv_item(const float* W, int Nsrc, int K, int k0, int scol, bf16_t* WT, int drow, const float* gain, float cscale, LAS float* scr, int lane) {
#pragma unroll 8
    for (int i = 0; i < 32; ++i) { const int kk = 2 * i + (lane >> 5); const float gg = gain ? gain[k0 + kk] * cscale : cscale;
        scr[kk * 33 + (lane & 31)] = W[(size_t)(k0 + kk) * Nsrc + scol + (lane & 31)] * gg; }
    asm volatile("s_waitcnt lgkmcnt(0)" ::: "memory");
    const int c = lane & 7;
#pragma unroll
    for (int j = 0; j < 4; ++j) { const int n = (lane >> 3) + 8 * j; const LAS float* s = scr + (8 * c) * 33 + n;
        u32x4 o; o.x = cvtpk(s[0 * 33], s[1 * 33]); o.y = cvtpk(s[2 * 33], s[3 * 33]); o.z = cvtpk(s[4 * 33], s[5 * 33]); o.w = cvtpk(s[6 * 33], s[7 * 33]);
        *(u32x4*)(WT + (size_t)(drow + n) * K + k0 + 8 * c) = o; }
    asm volatile("s_waitcnt lgkmcnt(0)" ::: "memory");
}


#define XB_TMO      128
#define XB_XCNT(j)  (256  + 64 * (j))
#define XB_XSUB(j)  (1280 + 64 * (j))
#define XB_XGEN(j)  (2304 + 64 * (j))
#define XB_TOP      3328
#define XB_TOPGEN   3392
#define XCD_BAR_WORDS 3456
#define XB_SPIN_CAP (1u << 22)
__device__ __forceinline__ unsigned xb_ld(unsigned* p)              { return __hip_atomic_load(p, __ATOMIC_RELAXED, __HIP_MEMORY_SCOPE_AGENT); }
__device__ __forceinline__ unsigned xb_add(unsigned* p, unsigned v) { return __hip_atomic_fetch_add(p, v, __ATOMIC_RELAXED, __HIP_MEMORY_SCOPE_AGENT); }
__device__ __forceinline__ unsigned xb_xcc_id() { return (unsigned)__builtin_amdgcn_s_getreg((3 << 11) | 20) & 0xFu; }
#define XB_SPIN(cond, bar) do { unsigned _sp = 0; while (cond) { __builtin_amdgcn_s_sleep(1); \
    if ((++_sp & 255u) == 0u) { if (xb_ld(&(bar)[XB_TMO])) break; if (_sp > XB_SPIN_CAP) { atomicAdd(&(bar)[XB_TMO], 1u); break; } } } } while (0)
struct XcdBarrier { unsigned* bar; unsigned x; volatile LAS unsigned* st; };
__device__ __forceinline__ XcdBarrier xcd_barrier_post(unsigned* bar, volatile LAS unsigned* st) {
    XcdBarrier b; b.bar = bar; b.x = xb_xcc_id(); b.st = st;
    if (threadIdx.x == 0) (void)xb_add(&bar[XB_XCNT(b.x)], 1u);
    return b;
}
__device__ __forceinline__ void xcd_barrier_complete(unsigned* bar, unsigned x, unsigned& nloc, unsigned& nx) {
    const unsigned G = gridDim.x * gridDim.y * gridDim.z;
    unsigned sum, cnt, mine, sp = 0u;
    for (;;) {
        sum = 0u; cnt = 0u; mine = 0u;
#pragma unroll
        for (unsigned j = 0; j < 16; ++j) { const unsigned c = xb_ld(&bar[XB_XCNT(j)]); sum += c; cnt += (c > 0u) ? 1u : 0u; mine = (j == x) ? c : mine; }
        if (sum == G) break;
        __builtin_amdgcn_s_sleep(1);
        if ((++sp & 255u) == 0u) { if (xb_ld(&bar[XB_TMO])) break; if (sp > XB_SPIN_CAP) { atomicAdd(&bar[XB_TMO], 1u); break; } }
    }
    nloc = mine > 0u ? mine : 1u; nx = cnt > 0u ? cnt : 1u;
}
__device__ __forceinline__ void xcd_barrier(const XcdBarrier& b) {
    asm volatile("s_waitcnt vmcnt(0)" ::: "memory");
    __syncthreads();
    if (threadIdx.x == 0) {
        unsigned* bar = b.bar;
        __builtin_amdgcn_s_waitcnt(0);
        unsigned nloc = b.st[0], nx = b.st[1];
        if (nloc == 0u) { xcd_barrier_complete(bar, b.x, nloc, nx); b.st[0] = nloc; b.st[1] = nx; }
        const unsigned old = xb_add(&bar[XB_XSUB(b.x)], 1u);
        const unsigned gen = old / nloc;
        if (old + 1u == (gen + 1u) * nloc) {
            __builtin_amdgcn_fence(__ATOMIC_RELEASE, "agent");
            asm volatile("s_waitcnt vmcnt(0)" ::: "memory");
            const unsigned og = xb_add(&bar[XB_TOP], 1u);
            const unsigned tg = og / nx;
            if (og + 1u == (tg + 1u) * nx) xb_add(&bar[XB_TOPGEN], 1u);
            else XB_SPIN(xb_ld(&bar[XB_TOPGEN]) == tg, bar);
            __builtin_amdgcn_fence(__ATOMIC_ACQUIRE, "agent");
            xb_add(&bar[XB_XGEN(b.x)], 1u);
            asm volatile("s_waitcnt vmcnt(0)" ::: "memory");
        } else {
            XB_SPIN(xb_ld(&bar[XB_XGEN(b.x)]) == gen, bar);
            __builtin_amdgcn_fence(__ATOMIC_ACQUIRE, "agent");
            asm volatile("s_waitcnt vmcnt(0)" ::: "memory");
        }
    }
    __syncthreads();
}
constexpr size_t OFF_BAR = 8 * MiB + 512 * 1024;
constexpr int MISC_OFF = 135168;

struct Args {
    const float* x; const float* meta; const float* t5; const float* norm_ffn1; const float* w_ffn1_in; const float* w_ffn1_out; const float* norm_mix; const float* w_in;
    const float* lq1; const float* lk1; const float* lq2; const float* lk2; const float* subg; const float* rpb; const float* sink;
    const float* w_branch; const float* w_gate; const float* w_out; const float* norm_ffn2; const float* w_ffn2_in; const float* w_ffn2_out; const float* final_norm;
    float* out; unsigned char* ws;
};

constexpr int LDS_BYTES = 136 * 1024;
#ifndef ATT_REPS
#define ATT_REPS 1
#endif

__device__ __forceinline__ void conv_layer(const Args& a, int l, bf16_t* WB, LAS unsigned char* lds, int ngw) {
    int tid = threadIdx.x; asm volatile("" : "+v"(tid));
    const int lane = tid & 63, wave = __builtin_amdgcn_readfirstlane(tid >> 6), gw = blockIdx.x * 8 + wave;
    LAS float* scr = (LAS float*)(lds + wave * 16384);
    constexpr int I1 = 16 * 176, I2 = 44 * 32, I3 = 16 * 120, I4 = 3 * 16 * 32, I5 = 3 * 8 * 32, I6 = 16 * 32;
    constexpr int NIT = I1 + I2 + I3 + I4 + I5 + I6 + I1 + I2;
    for (int it = gw; it < NIT; it += ngw) {
        int r = it;
        if (r < I1 || (r >= I1 + I2 + I3 + I4 + I5 + I6 && r < I1 + I2 + I3 + I4 + I5 + I6 + I1)) {
            const bool second = r >= I1; if (second) r -= I1 + I2 + I3 + I4 + I5 + I6;
            const int kb = r / 176, db = r % 176, pn = db >> 3, o8 = db & 7; const int scol = (o8 >> 2) * DFF + 128 * pn + (o8 & 3) * 32;
            conv_item((second ? a.w_ffn2_in : a.w_ffn1_in) + (size_t)l * 1024 * 5632, 5632, 1024, kb * 64, scol, WB + (second ? WO_W3 : WO_W1), db * 32, (second ? a.norm_ffn2 : a.norm_ffn1) + l * 1024, 1.f, scr, lane);
            continue; }
        r -= I1;
        if (r < I2 || r >= I2 + I3 + I4 + I5 + I6 + I1) {
            const bool second = r >= I2; if (second) r -= I2 + I3 + I4 + I5 + I6 + I1;
            const int kb = r / 32, db = r % 32;
            conv_item((second ? a.w_ffn2_out : a.w_ffn1_out) + (size_t)l * 2816 * 1024, 1024, 2816, kb * 64, db * 32, WB + (second ? WO_W4 : WO_W2), db * 32, nullptr, 1.f, scr, lane);
            continue; }
        r -= I2;
        if (r < I3) { const int kb = r / 120, db = r % 120, col = db * 32;
            const bool isq = col < 512 || (col >= 1536 && col < 2048) || (col >= 3072 && col < 3584);
            conv_item(a.w_in + (size_t)l * 1024 * INC, INC, 1024, kb * 64, col, WB + WO_WIN, col, a.norm_mix + l * 1024, isq ? 0.125f * LOG2E : 1.f, scr, lane);
            continue; }
        r -= I3;
        if (r < I4) { const int gi = r / 512, rr = r % 512, kb = rr / 32, db = rr % 32;
            conv_item(a.w_gate + ((size_t)l * 3 + gi) * 1024 * 1024, 1024, 1024, kb * 64, db * 32, WB + WO_WG, gi * 1024 + db * 32, a.norm_mix + l * 1024, 1.f, scr, lane);
            continue; }
        r -= I4;
        if (r < I5) { const int gi = r / 256, rr = r % 256, kb = rr / 32, db = rr % 32;
            conv_item(a.w_branch + ((size_t)l * 3 + gi) * 512 * 1024, 1024, 512, kb * 64, db * 32, WB + WO_WB + (size_t)gi * 1024 * 512, db * 32, nullptr, 1.f, scr, lane);
            continue; }
        r -= I5;
        { const int kb = r / 32, db = r % 32;
          conv_item(a.w_out + (size_t)l * 1024 * 1024, 1024, 1024, kb * 64, db * 32, WB + WO_WO, db * 32, nullptr, 1.f, scr, lane); }
    }
}

#define GSYNC0() do { asm volatile("s_waitcnt vmcnt(0) lgkmcnt(0)" ::: "memory"); __builtin_amdgcn_fence(__ATOMIC_RELEASE, "agent"); grid.sync(); __builtin_amdgcn_fence(__ATOMIC_ACQUIRE, "agent"); } while (0)
__global__ void __launch_bounds__(512, 2) fwd_kernel(Args a) {
    extern __shared__ __attribute__((aligned(16))) unsigned char lds_raw[];
    LAS unsigned char* lds = (LAS unsigned char*)lds_raw;
    cg::grid_group grid = cg::this_grid();
    { volatile LAS unsigned* misc = (volatile LAS unsigned*)(lds + MISC_OFF); if (threadIdx.x < 2) misc[threadIdx.x] = 0u; __syncthreads(); }
    XcdBarrier xbar = xcd_barrier_post((unsigned*)(a.ws + OFF_BAR), (volatile LAS unsigned*)(lds + MISC_OFF));
#define XSYNC() xcd_barrier(xbar)
    const int G = gridDim.x, ngw = G * 8;
    float* SS = (float*)(a.ws + OFF_SS); bf16_t* HB = (bf16_t*)(a.ws + OFF_HB); bf16_t* WB = (bf16_t*)(a.ws + OFF_W);
    bf16_t* Y = (bf16_t*)(a.ws + OFF_Y); bf16_t* MG = (bf16_t*)(a.ws + OFF_MG); bf16_t* R = (bf16_t*)(a.ws + OFF_R);
    bf16_t* YA = Y; bf16_t* YB = Y + (size_t)MROWS * 512; bf16_t* YC = Y + (size_t)2 * MROWS * 512;

    { int tid1 = threadIdx.x; asm volatile("" : "+v"(tid1)); const int lane = tid1 & 63, gw = blockIdx.x * 8 + __builtin_amdgcn_readfirstlane(tid1 >> 6);
    for (int row = gw; row < MROWS; row += ngw) {
        const int b = row / LT, t = row - b * LT;
        const float* src = t < NMETA ? a.meta + (size_t)t * DM : a.x + ((size_t)b * SEQ + (t - NMETA)) * DM;
        bf16_t* hb = HB + (size_t)row * DM; float q = 0.f;
#pragma unroll
        for (int j = 0; j < 2; ++j) { const f32x4 v0 = *(const f32x4*)(src + j * 512 + lane * 8), v1 = *(const f32x4*)(src + j * 512 + lane * 8 + 4);
            q += ((v0[0] * v0[0] + v0[1] * v0[1]) + (v0[2] * v0[2] + v0[3] * v0[3])) + ((v1[0] * v1[0] + v1[1] * v1[1]) + (v1[2] * v1[2] + v1[3] * v1[3]));
            u32x4 wv; wv.x = cvtpk(v0[0], v0[1]); wv.y = cvtpk(v0[2], v0[3]); wv.z = cvtpk(v1[0], v1[1]); wv.w = cvtpk(v1[2], v1[3]); *(u32x4*)(hb + j * 512 + lane * 8) = wv; }
#pragma unroll
        for (int s = 1; s < 64; s <<= 1) q += __shfl_xor(q, s);
        if (lane < 16) SS[(size_t)row * 16 + lane] = lane == 0 ? q : 0.f;
    } }

    for (int l = 0; l < DEPTH; ++l) {
        conv_layer(a, l, WB, lds, ngw);
        if (gridDim.x == 0) GSYNC0();
        XSYNC();
        constexpr size_t SSB = (size_t)MROWS * 16; const float* ss0 = SS + ((3 * l) & 1) * SSB; float* ss1 = SS + ((3 * l + 1) & 1) * SSB; float* ss2 = SS + ((3 * l + 2) & 1) * SSB; float* ss3 = SS + ((3 * l + 3) & 1) * SSB;
        pg8::StaticOrder S;
        { pg8::Gemm g{HB, WB + WO_W1, MMAIN, 5632, 1024}; S.init(MMAIN, 5632, G, blockIdx.x); EpiSwiGLU E{R, ss0}; pg8::gemm_phase(lds, g, S, E);
          TEpiSwi TE{R, ss0}; gemm_tail2<TEpiSwi, true>(lds, HB, WB + WO_W1, 1024, 8 * 88, TE); }
        XSYNC();
        { pg8::Gemm g{R, WB + WO_W2, MMAIN, 1024, DFF}; S.init(MMAIN, 1024, G, blockIdx.x); EpiRes E{HB, ss1, 0.5f}; pg8::gemm_phase(lds, g, S, E);
          TEpiRes TE{HB, ss1, 0.5f}; gemm_tail(lds, R, WB + WO_W2, DFF, TE); }
        XSYNC();
        { pg8::Gemm g{HB, WB + WO_WIN, MMAIN, INC, 1024}; S.init(MMAIN, INC, G, blockIdx.x); EpiRow<0> E{R, INC, ss1}; pg8::gemm_phase(lds, g, S, E);
          TEpiRow<0> TE{R, INC, ss1}; gemm_tail2<TEpiRow<0>, false>(lds, HB, WB + WO_WIN, 1024, 8 * 60, TE); }
        XSYNC();
        {
          AttnP P{R, YA, YB, YC, a.t5, a.rpb + (size_t)l * 8 * 465, a.sink + l * 8, a.subg + l * 128, a.lq1 + l * 64, a.lk1 + l * 64, a.lq2 + l * 64, a.lk2 + l * 64,
                  l};
          for (int rep = 0; rep < ATT_REPS; ++rep) {
          if (G == 256) { const int x = blockIdx.x & 7, jx = blockIdx.x >> 3;
              for (int r = 0; r < 8; ++r) attn_unit_A(P, (x + 8 * r) * 33 + jx, (LAS char*)lds);
              if (jx < 8) attn_unit_A(P, (x + 8 * jx) * 33 + 32, (LAS char*)lds);
          } else { for (int u = blockIdx.x; u < NUA; u += G) attn_unit_A(P, u, (LAS char*)lds); }
          constexpr int NBC = NUB + NUC, N1 = 12, NLOW = 64 * N1;
          const int wg = blockIdx.x;
          int keyB = -1, keyC = -1;
#define RUN_BC(j) do { const int u_ = (j) >> 1, k_ = u_ / (NBATCH * 65); if ((j) & 1) { attn_unit<2>(P, u_, (LAS char*)lds, k_ != keyC); keyC = k_; } else { attn_unit<1>(P, u_, (LAS char*)lds, k_ != keyB); keyB = k_; } } while (0)
          if (G == 256) {
              if (wg < 64) { for (int j = (wg & 7) * 8 + (wg >> 3); j < NLOW; j += 64) RUN_BC(j); }
              else { for (int j = NLOW + (wg & 7) * 24 + ((wg - 64) >> 3); j < NBC; j += 192) RUN_BC(j); }
          } else { for (int j = wg; j < NBC; j += G) RUN_BC(j); }
#undef RUN_BC
          } }
        XSYNC();
        { pg8::Gemm g{HB, WB + WO_WG, MMAIN, 3072, 1024}; S.init(MMAIN, 3072, G, blockIdx.x); EpiRow<1> E{R, 3072, ss1}; pg8::gemm_phase(lds, g, S, E);
          TEpiRow<1> TE{R, 3072, ss1}; gemm_tail2<TEpiRow<1>, false>(lds, HB, WB + WO_WG, 1024, 8 * 48, TE); }
        XSYNC();
        { pg8::Gemm g{Y, WB + WO_WB, MMAIN, 1024, 512}; pg8::BranchOrder BS; BS.S.init(MMAIN, 1024, G, blockIdx.x);
          EpiGate E{MG, R}; pg8::gemm_phase(lds, g, BS, E);
          __syncthreads();
          for (int gi = 0; gi < 3; ++gi) { TEpiGate TE{MG, R, gi, gi == 0}; gemm_tail(lds, Y + (size_t)gi * MROWS * 512, WB + WO_WB + (size_t)gi * 1024 * 512, 512, TE); } }
        XSYNC();
        { pg8::Gemm g{MG, WB + WO_WO, MMAIN, 1024, 1024}; S.init(MMAIN, 1024, G, blockIdx.x); EpiRes E{HB, ss2, 1.0f}; pg8::gemm_phase(lds, g, S, E);
          TEpiRes TE{HB, ss2, 1.0f}; gemm_tail(lds, MG, WB + WO_WO, 1024, TE); }
        XSYNC();
        { pg8::Gemm g{HB, WB + WO_W3, MMAIN, 5632, 1024}; S.init(MMAIN, 5632, G, blockIdx.x); EpiSwiGLU E{R, ss2}; pg8::gemm_phase(lds, g, S, E);
          TEpiSwi TE{R, ss2}; gemm_tail2<TEpiSwi, true>(lds, HB, WB + WO_W3, 1024, 8 * 88, TE); }
        XSYNC();
        { pg8::Gemm g{R, WB + WO_W4, MMAIN, 1024, DFF}; S.init(MMAIN, 1024, G, blockIdx.x); EpiRes E{HB, ss3, 0.5f}; pg8::gemm_phase(lds, g, S, E);
          TEpiRes TE{HB, ss3, 0.5f}; gemm_tail(lds, R, WB + WO_W4, DFF, TE); }
        XSYNC();
    }
    { const float* ssf = SS; int tid2 = threadIdx.x; asm volatile("" : "+v"(tid2)); const int lane = tid2 & 63, gw = blockIdx.x * 8 + __builtin_amdgcn_readfirstlane(tid2 >> 6);
      for (int row = gw; row < NBATCH * SEQ; row += ngw) { const int b = row / SEQ, sq = row - b * SEQ, m = b * LT + NMETA + sq; const float rs = rstd_of(ssf, m);
          const bf16_t* hp = HB + (size_t)m * DM; float* p = a.out + (size_t)row * DM;
#pragma unroll
          for (int j = 0; j < 2; ++j) { const u32x4 h4 = *(const u32x4*)(hp + j * 512 + lane * 8);
              const f32x4 g0 = *(const f32x4*)(a.final_norm + j * 512 + lane * 8), g1 = *(const f32x4*)(a.final_norm + j * 512 + lane * 8 + 4);
              f32x4 v0 = {bflo(h4.x), bfhi(h4.x), bflo(h4.y), bfhi(h4.y)}, v1 = {bflo(h4.z), bfhi(h4.z), bflo(h4.w), bfhi(h4.w)};
              v0 = v0 * rs * g0; v1 = v1 * rs * g1; *(f32x4*)(p + j * 512 + lane * 8) = v0; *(f32x4*)(p + j * 512 + lane * 8 + 4) = v1; } } }
}

extern "C" void kernel_launch(void* const* d_in, const int* in_sizes, int n_in, void* d_out, int out_size, void* d_ws, size_t ws_size, hipStream_t stream) {
    static int grid_blocks = 0;
    if (!grid_blocks) {
        int dev = 0, cus = 0, per_cu = 0;
        hipGetDevice(&dev);
        hipDeviceGetAttribute(&cus, hipDeviceAttributeMultiprocessorCount, dev);
        hipFuncSetAttribute((const void*)fwd_kernel, hipFuncAttributeMaxDynamicSharedMemorySize, LDS_BYTES);
        hipOccupancyMaxActiveBlocksPerMultiprocessor(&per_cu, (const void*)fwd_kernel, 512, LDS_BYTES);
        if (per_cu < 1) { fprintf(stderr, "occupancy query returned %d\n", per_cu); per_cu = 1; }
        grid_blocks = cus * per_cu;
        if (ws_size < WS_END) fprintf(stderr, "workspace too small: %zu < %zu\n", ws_size, (size_t)WS_END);
    }
    Args a{};
    const float** f = (const float**)&a;
    for (int i = 0; i < 22; ++i) f[i] = (const float*)d_in[i];
    a.out = (float*)d_out; a.ws = (unsigned char*)d_ws;
    hipMemsetAsync((char*)d_ws + OFF_BAR, 0, 16384, stream);
    void* args[] = {&a};
    hipError_t e = hipLaunchCooperativeKernel((const void*)fwd_kernel, dim3(grid_blocks), dim3(512), args, LDS_BYTES, stream);
    if (e != hipSuccess) fprintf(stderr, "cooperative launch failed: %s (grid %d)\n", hipGetErrorString(e), grid_blocks);
}
```

```cpp
#include <hip/hip_runtime.h>
#include <hip/hip_cooperative_groups.h>
#include <cstdio>
#include <cstdint>
namespace cg = cooperative_groups;

#define LAS __attribute__((address_space(3)))
typedef unsigned short bf16_t;
typedef short bf16x8 __attribute__((ext_vector_type(8)));
typedef short s16x4 __attribute__((ext_vector_type(4)));
typedef float f32x4 __attribute__((ext_vector_type(4)));
typedef float f32x16 __attribute__((ext_vector_type(16)));
typedef unsigned u32x4 __attribute__((ext_vector_type(4)));
typedef unsigned u32x2 __attribute__((ext_vector_type(2)));
typedef float f32x2_t __attribute__((ext_vector_type(2)));
typedef __bf16 bf16x2_t __attribute__((ext_vector_type(2)));

constexpr int DM = 1024, NBATCH = 16, SEQ = 4096, NMETA = 16, LT = SEQ + NMETA, MROWS = NBATCH * LT, DEPTH = 4, DFF = 2816, INC = 3840;
constexpr float EPS = 1e-6f, LOG2E = 1.4426950408889634f, NEGV = -1e30f;
static_assert(MROWS % 256 == 0, "rows");
constexpr size_t MiB = 1u << 20;
constexpr size_t OFF_SS = 0;
constexpr size_t OFF_HMETA = 9 * MiB;
constexpr size_t OFF_HB = 10 * MiB;
constexpr size_t OFF_W = 139 * MiB;
constexpr size_t OFF_Y = 191 * MiB;
constexpr size_t OFF_MG = 384 * MiB;
constexpr size_t OFF_R = 513 * MiB;
constexpr size_t WS_END = OFF_R + (size_t)MROWS * INC * 2;
static_assert(WS_END <= 1024 * MiB, "ws");
constexpr size_t WO_W1 = 0, WO_W2 = WO_W1 + (size_t)5632 * 1024, WO_WIN = WO_W2 + (size_t)1024 * 2816, WO_WG = WO_WIN + (size_t)3840 * 1024,
                 WO_WB = WO_WG + (size_t)3072 * 1024, WO_WO = WO_WB + (size_t)3 * 1024 * 512, WO_W3 = WO_WO + (size_t)1024 * 1024,
                 WO_W4 = WO_W3 + (size_t)5632 * 1024, WO_END = WO_W4 + (size_t)1024 * 2816;
static_assert(WO_END * 2 <= 52 * MiB, "weights");

__device__ __forceinline__ unsigned cvtpk(float lo, float hi) { f32x2_t v = {lo, hi}; bf16x2_t b = __builtin_convertvector(v, bf16x2_t); return __builtin_bit_cast(unsigned, b); }
__device__ __forceinline__ float bflo(unsigned u) { return __uint_as_float(u << 16); }
__device__ __forceinline__ float bfhi(unsigned u) { return __uint_as_float(u & 0xffff0000u); }

namespace pg8 {
constexpr int BM = 256, BK = 64, HALF = 128, HTB = HALF * BK * 2, STAGE_BYTES = 8 * HTB, NXCD = 8, WGM = 8;
__device__ __forceinline__ int lds_byte(int r, int c) { const int st = (r >> 4) * 2 + (c >> 5), rr = r & 15, cc = c & 31, ob = rr * 64 + cc * 2; return st * 1024 + (ob ^ (((ob >> 9) & 1) << 5)); }
__device__ __forceinline__ void stage_rc(int b, int& R, int& C) { const int st = b / 1024, sb = b % 1024, swz = sb ^ (((sb >> 9) & 1) << 5); R = (st >> 1) * 16 + swz / 64; C = (st & 1) * 32 + (swz % 64) / 2; }
__device__ __forceinline__ int perm32(int rho) { const int n = rho >> 4, i = rho & 15; return 8 * (i >> 2) + 4 * n + (i & 3); }
struct Unit { int pm, pn; };
struct Gemm { const bf16_t* A; const bf16_t* Bt; int M, N, K; };
struct StaticOrder {
    int nM, nN, nwg, G, c;
    __device__ void init(int M, int N, int G_, int c_) { nM = M / BM; nN = N / BM; nwg = nM * nN; G = G_; c = c_; }
    __device__ bool next(int i, Unit& u) const {
        const long L = (long)i * G + c; if (L >= nwg) return false;
        int wgid = (int)L; { const int q = nwg / NXCD, r = nwg % NXCD, xcd = wgid % NXCD, off = wgid / NXCD; wgid = (xcd < r ? xcd * (q + 1) : r * (q + 1) + (xcd - r) * q) + off; }
        const int nig = WGM * nN, gid = wgid / nig, fm = gid * WGM, gsz = (nM - fm) < WGM ? (nM - fm) : WGM;
        u.pm = fm + ((wgid % nig) % gsz); u.pn = (wgid % nig) / gsz; return true;
    }
};

struct BranchOrder { StaticOrder S;
    __device__ bool next(int i, Unit& u) const { const int bi = i / 3, gi = i - bi * 3; Unit b; if (!S.next(bi, b)) return false; u.pm = gi * 257 + b.pm; u.pn = gi * 4 + b.pn; return true; } };
template <class Epi, class Sched>
__device__ __forceinline__ void gemm_phase(LAS unsigned char* lds, const Gemm g, const Sched& S, const Epi& E) {
    int tid = threadIdx.x; asm volatile("" : "+v"(tid));
    const int wid = __builtin_amdgcn_readfirstlane(tid >> 6), lane = tid & 63, wr = wid >> 2, wc = wid & 3, fr = lane & 15, fq = lane >> 4;
    int K = g.K; const char* gA = (const char*)g.A; const char* gB = (const char*)g.Bt;
    asm volatile("" : "+s"(K), "+s"(gA), "+s"(gB));
    const int nt = K / BK;
    unsigned voffA[2], voffB[2];
#pragma unroll
    for (int i = 0; i < 2; ++i) { int R, C; stage_rc(tid * 16 + i * 8192, R, C); const int Rb = Epi::PERM ? ((R & ~31) + perm32(R & 31)) : R;
        voffA[i] = (unsigned)(R * K + C) * 2u; voffB[i] = (unsigned)(Rb * K + C) * 2u; }
    const size_t kstep = (size_t)(BK * 2);
    const size_t hstep = (size_t)HALF * K * 2;
    const size_t tstep = 2 * hstep;
    const unsigned ldsw = (unsigned)wid * 1024u;
    const int aoff = lds_byte(wr * 64 + fr, fq * 8), boff = lds_byte(wc * 32 + fr, fq * 8);
#define PG8_SA(b, h) (((b) * 2 + (h)) * HTB)
#define PG8_SB(b, h) ((4 + (b) * 2 + (h)) * HTB)
#define PG8_STAGE(bufoff, gbase, voff) do { _Pragma("unroll") for (int _i = 0; _i < 2; ++_i) \
        __builtin_amdgcn_global_load_lds((const unsigned*)((const char*)(gbase) + (voff)[_i]), (LAS unsigned*)(lds + (bufoff) + ldsw + _i * 8192), 16, 0, 0); } while (0)
#define PG8_LDA(dst, b, h) do { _Pragma("unroll") for (int m = 0; m < 4; ++m) _Pragma("unroll") for (int k = 0; k < 2; ++k) dst[m][k] = *(const LAS bf16x8*)(lds + PG8_SA(b, h) + aoff + m * 2048 + k * 1024); } while (0)
#define PG8_LDB(dst, b, h) do { _Pragma("unroll") for (int n = 0; n < 2; ++n) _Pragma("unroll") for (int k = 0; k < 2; ++k) dst[n][k] = *(const LAS bf16x8*)(lds + PG8_SB(b, h) + boff + n * 2048 + k * 1024); } while (0)
#define PG8_MMA(ai, bj, At, Bt) do { __builtin_amdgcn_s_setprio(1); _Pragma("unroll") for (int m = 0; m < 4; ++m) _Pragma("unroll") for (int n = 0; n < 2; ++n) _Pragma("unroll") for (int k = 0; k < 2; ++k) \
        acc[ai][bj][m][n] = __builtin_amdgcn_mfma_f32_16x16x32_bf16(Bt[n][k], At[m][k], acc[ai][bj][m][n], 0, 0, 0); __builtin_amdgcn_s_setprio(0); } while (0)
#define PG8_WAIT_V(n) asm volatile("s_waitcnt vmcnt(" #n ")" ::: "memory")
#define PG8_WAIT_L(n) asm volatile("s_waitcnt lgkmcnt(" #n ")" ::: "memory")
#define PG8_BAR __builtin_amdgcn_s_barrier()
#define PG8_SCHED __builtin_amdgcn_sched_barrier(0)
    Unit cur, nxt; int ui = 0;
    if (!S.next(0, cur)) return;
    f32x4 acc[2][2][4][2];
#pragma unroll
    for (int a = 0; a < 2; ++a)
#pragma unroll
        for (int b = 0; b < 2; ++b)
#pragma unroll
            for (int m = 0; m < 4; ++m)
#pragma unroll
                for (int n = 0; n < 2; ++n) acc[a][b][m][n] = (f32x4){0.f, 0.f, 0.f, 0.f};
    bf16x8 At[4][2], B0[2][2], B1[2][2];
    const char* cA = gA + (size_t)cur.pm * tstep; const char* cB = gB + (size_t)cur.pn * tstep;
    PG8_STAGE(PG8_SB(0, 0), cB, voffB); PG8_STAGE(PG8_SB(0, 1), cB + hstep, voffB); PG8_STAGE(PG8_SA(0, 0), cA, voffA); PG8_STAGE(PG8_SA(0, 1), cA + hstep, voffA);
    if (wr == 1) PG8_BAR;
    PG8_WAIT_V(2); PG8_BAR;
    PG8_STAGE(PG8_SB(1, 0), cB + kstep, voffB); PG8_STAGE(PG8_SA(1, 0), cA + kstep, voffA); PG8_STAGE(PG8_SB(1, 1), cB + hstep + kstep, voffB);
    PG8_WAIT_V(6); PG8_BAR;
    for (;;) {
        const bool has_next = S.next(ui + 1, nxt);
        const char* nA = has_next ? gA + (size_t)nxt.pm * tstep : cA; const char* nB = has_next ? gB + (size_t)nxt.pn * tstep : cB;
        for (int t = 0; t < nt; t += 2) {
            const bool last = (t == nt - 2);
            const char* a1 = cA + (size_t)(t + 1) * kstep;
            const char* a2 = last ? nA : cA + (size_t)(t + 2) * kstep; const char* b2 = last ? nB : cB + (size_t)(t + 2) * kstep;
            const char* a3 = a2 + kstep; const char* b3 = b2 + kstep;
            PG8_LDB(B0, 0, 0); PG8_LDB(B1, 0, 1); PG8_SCHED; PG8_LDA(At, 0, 0); PG8_STAGE(PG8_SA(1, 1), a1 + hstep, voffA);
            PG8_WAIT_V(8); PG8_WAIT_L(0); PG8_BAR; PG8_MMA(0, 0, At, B0); PG8_MMA(0, 1, At, B1); PG8_BAR; PG8_SCHED;
            PG8_LDA(At, 0, 1); PG8_STAGE(PG8_SB(0, 0), b2, voffB); PG8_STAGE(PG8_SB(0, 1), b2 + hstep, voffB); PG8_STAGE(PG8_SA(0, 0), a2, voffA);
            PG8_WAIT_V(8); PG8_WAIT_L(0); PG8_BAR; PG8_MMA(1, 0, At, B0); PG8_MMA(1, 1, At, B1); PG8_BAR; PG8_SCHED;
            PG8_LDB(B0, 1, 0); PG8_LDB(B1, 1, 1); PG8_SCHED; PG8_LDA(At, 1, 0); PG8_STAGE(PG8_SA(0, 1), a2 + hstep, voffA);
            PG8_WAIT_V(8); PG8_WAIT_L(0); PG8_BAR; PG8_MMA(0, 0, At, B0); PG8_MMA(0, 1, At, B1); PG8_BAR; PG8_SCHED;
            PG8_LDA(At, 1, 1); PG8_STAGE(PG8_SB(1, 0), b3, voffB); PG8_STAGE(PG8_SB(1, 1), b3 + hstep, voffB); PG8_STAGE(PG8_SA(1, 0), a3, voffA);
            PG8_WAIT_V(8); PG8_WAIT_L(0); PG8_BAR; PG8_MMA(1, 0, At, B0); PG8_MMA(1, 1, At, B1); PG8_BAR; PG8_SCHED;
        }
        if (wr == 0) PG8_BAR;
        E(acc, cur, wr, wc, fr, fq);
        if (!has_next) break;
#pragma unroll
        for (int a = 0; a < 2; ++a)
#pragma unroll
            for (int b = 0; b < 2; ++b)
#pragma unroll
                for (int m = 0; m < 4; ++m)
#pragma unroll
                    for (int n = 0; n < 2; ++n) acc[a][b][m][n] = (f32x4){0.f, 0.f, 0.f, 0.f};
        cur = nxt; cA = nA; cB = nB; ++ui;
        if (wr == 1) PG8_BAR;
    }
    PG8_WAIT_V(0);
    PG8_BAR;
#undef PG8_SA
#undef PG8_SB
#undef PG8_STAGE
#undef PG8_LDA
#undef PG8_LDB
#undef PG8_MMA
#undef PG8_WAIT_V
#undef PG8_WAIT_L
#undef PG8_BAR
#undef PG8_SCHED
}
}
using pg8::Unit;
typedef f32x4 AccT[2][2][4][2];

__device__ __forceinline__ float xsum_16_32(float v) {
    const auto a = __builtin_amdgcn_permlane16_swap(__float_as_uint(v), __float_as_uint(v), false, false); v = __uint_as_float(a[0]) + __uint_as_float(a[1]);
    const auto b = __builtin_amdgcn_permlane32_swap(__float_as_uint(v), __float_as_uint(v), false, false); return __uint_as_float(b[0]) + __uint_as_float(b[1]);
}
__device__ __forceinline__ float rstd_of(const float* ss, int row) {
    const f32x4* p = (const f32x4*)(ss + (size_t)row * 16); const f32x4 a = p[0], b = p[1], c = p[2], d = p[3];
    const float t = ((a[0] + a[1]) + (a[2] + a[3])) + ((b[0] + b[1]) + (b[2] + b[3])) + ((c[0] + c[1]) + (c[2] + c[3])) + ((d[0] + d[1]) + (d[2] + d[3]));
    return rsqrtf(t * (1.0f / DM) + EPS); }
__device__ __forceinline__ float* hrow(float* hout, float* hmeta, int row) {
    const int b = row / LT, t = row - b * LT;
    return t < NMETA ? hmeta + (size_t)(b * NMETA + t) * DM : hout + ((size_t)b * SEQ + (t - NMETA)) * DM;
}
__device__ __forceinline__ float rstd_coop(const float* ss, int row, int fq) {
    const f32x4 a = *(const f32x4*)(ss + (size_t)row * 16 + fq * 4); float t = (a[0] + a[1]) + (a[2] + a[3]);
    t = xsum_16_32(t);
    return rsqrtf(t * (1.0f / DM) + EPS); }
__device__ __forceinline__ float silu_f(float g) { return g * __builtin_amdgcn_rcpf(1.0f + __builtin_amdgcn_exp2f(-g * LOG2E)); }
__device__ __forceinline__ float sigm_f(float g) { return __builtin_amdgcn_rcpf(1.0f + __builtin_amdgcn_exp2f(-g * LOG2E)); }

struct EpiSwiGLU { static constexpr bool PERM = true; bf16_t* O; const float* ss;
    __device__ __forceinline__ void operator()(const AccT& acc, const Unit& u, int wr, int wc, int fr, int fq) const {
        const int row0 = u.pm * 256 + wr * 64 + fr, col0 = u.pn * 128 + wc * 32 + 8 * fq;
        float rsv[2][4];
        { f32x4 pv[2][4];
#pragma unroll
          for (int ai = 0; ai < 2; ++ai)
#pragma unroll
              for (int m = 0; m < 4; ++m) pv[ai][m] = *(const f32x4*)(ss + (size_t)(row0 + ai * 128 + m * 16) * 16 + fq * 4);
#pragma unroll
          for (int ai = 0; ai < 2; ++ai)
#pragma unroll
              for (int m = 0; m < 4; ++m) { const f32x4 a = pv[ai][m]; float t = (a[0] + a[1]) + (a[2] + a[3]); t = xsum_16_32(t); rsv[ai][m] = rsqrtf(t * (1.0f / DM) + EPS); } }
#pragma unroll
        for (int ai = 0; ai < 2; ++ai)
#pragma unroll
            for (int m = 0; m < 4; ++m) { const int row = row0 + ai * 128 + m * 16; const float rs = rsv[ai][m]; const float c1 = -rs * LOG2E, c2 = rs * rs;
                float a[8];
#pragma unroll
                for (int n = 0; n < 2; ++n)
#pragma unroll
                    for (int j = 0; j < 4; ++j) { const float g_ = acc[ai][0][m][n][j]; a[n * 4 + j] = (g_ * acc[ai][1][m][n][j]) * (c2 * __builtin_amdgcn_rcpf(1.0f + __builtin_amdgcn_exp2f(g_ * c1))); }
                u32x4 w; w.x = cvtpk(a[0], a[1]); w.y = cvtpk(a[2], a[3]); w.z = cvtpk(a[4], a[5]); w.w = cvtpk(a[6], a[7]);
                *(u32x4*)(O + (size_t)row * DFF + col0) = w; }
    }
};
struct EpiRes { static constexpr bool PERM = true; bf16_t* hb; float* ssn; float c;
    __device__ __forceinline__ void operator()(const AccT& acc, const Unit& u, int wr, int wc, int fr, int fq) const {
        const int row0 = u.pm * 256 + wr * 64 + fr, col0 = u.pn * 256 + wc * 32 + 8 * fq;
        bf16_t* bp0 = hb + (size_t)row0 * DM + col0;
        u32x4 hv[2][4][2];
#pragma unroll
        for (int ai = 0; ai < 2; ++ai)
#pragma unroll
            for (int m = 0; m < 4; ++m)
#pragma unroll
                for (int bj = 0; bj < 2; ++bj) hv[ai][m][bj] = *(const u32x4*)(bp0 + (size_t)(ai * 128 + m * 16) * DM + bj * 128);
#pragma unroll
        for (int ai = 0; ai < 2; ++ai)
#pragma unroll
            for (int m = 0; m < 4; ++m) { const int row = row0 + ai * 128 + m * 16; bf16_t* bp = bp0 + (size_t)(ai * 128 + m * 16) * DM; float q = 0.f;
#pragma unroll
                for (int bj = 0; bj < 2; ++bj) { const u32x4 h4 = hv[ai][m][bj];
                    f32x4 v0 = {bflo(h4.x), bfhi(h4.x), bflo(h4.y), bfhi(h4.y)}, v1 = {bflo(h4.z), bfhi(h4.z), bflo(h4.w), bfhi(h4.w)};
                    v0 = v0 + acc[ai][bj][m][0] * c; v1 = v1 + acc[ai][bj][m][1] * c;
                    q += ((v0[0] * v0[0] + v0[1] * v0[1]) + (v0[2] * v0[2] + v0[3] * v0[3])) + ((v1[0] * v1[0] + v1[1] * v1[1]) + (v1[2] * v1[2] + v1[3] * v1[3]));
                    u32x4 w; w.x = cvtpk(v0[0], v0[1]); w.y = cvtpk(v0[2], v0[3]); w.z = cvtpk(v1[0], v1[1]); w.w = cvtpk(v1[2], v1[3]); *(u32x4*)(bp + bj * 128) = w; }
                q = xsum_16_32(q);
                if (fq == 0) ssn[(size_t)row * 16 + u.pn * 4 + wc] = q; }
    }
};
template <int ACT> struct EpiRow { static constexpr bool PERM = true; bf16_t* O; int ldc; const float* ss;
    __device__ __forceinline__ void operator()(const AccT& acc, const Unit& u, int wr, int wc, int fr, int fq) const {
        const int row0 = u.pm * 256 + wr * 64 + fr, col0 = u.pn * 256 + wc * 32 + 8 * fq;
        float rsv[2][4];
        { f32x4 pv[2][4];
#pragma unroll
          for (int ai = 0; ai < 2; ++ai)
#pragma unroll
              for (int m = 0; m < 4; ++m) pv[ai][m] = *(const f32x4*)(ss + (size_t)(row0 + ai * 128 + m * 16) * 16 + fq * 4);
#pragma unroll
          for (int ai = 0; ai < 2; ++ai)
#pragma unroll
              for (int m = 0; m < 4; ++m) { const f32x4 a = pv[ai][m]; float t = (a[0] + a[1]) + (a[2] + a[3]); t = xsum_16_32(t); rsv[ai][m] = rsqrtf(t * (1.0f / DM) + EPS); } }
#pragma unroll
        for (int ai = 0; ai < 2; ++ai)
#pragma unroll
            for (int m = 0; m < 4; ++m) { const int row = row0 + ai * 128 + m * 16; const float rs = rsv[ai][m];
#pragma unroll
                for (int bj = 0; bj < 2; ++bj) { float a[8];
#pragma unroll
                    for (int n = 0; n < 2; ++n)
#pragma unroll
                        for (int j = 0; j < 4; ++j) { const float x_ = acc[ai][bj][m][n][j]; a[n * 4 + j] = ACT ? __builtin_amdgcn_rcpf(1.0f + __builtin_amdgcn_exp2f(x_ * (-rs * LOG2E))) : x_ * rs; }
                    u32x4 w; w.x = cvtpk(a[0], a[1]); w.y = cvtpk(a[2], a[3]); w.z = cvtpk(a[4], a[5]); w.w = cvtpk(a[6], a[7]);
                    *(u32x4*)(O + (size_t)row * ldc + col0 + bj * 128) = w; } }
    }
};
struct EpiGate { static constexpr bool PERM = true; bf16_t* Mg; const bf16_t* G;
    __device__ __forceinline__ void operator()(const AccT& acc, const Unit& u, int wr, int wc, int fr, int fq) const {
        const int gi = u.pn >> 2; const bool first = (gi == 0);
        const int row0 = (u.pm - gi * 257) * 256 + wr * 64 + fr, col0 = (u.pn & 3) * 256 + wc * 32 + 8 * fq;
#pragma unroll
        for (int ai = 0; ai < 2; ++ai) {
            u32x4 gv[4][2], mv[4][2];
#pragma unroll
            for (int m = 0; m < 4; ++m)
#pragma unroll
                for (int bj = 0; bj < 2; ++bj) { const int row = row0 + ai * 128 + m * 16;
                    gv[m][bj] = *(const u32x4*)(G + (size_t)row * 3072 + gi * 1024 + col0 + bj * 128);
                    mv[m][bj] = first ? (u32x4){0u, 0u, 0u, 0u} : *(const u32x4*)(Mg + (size_t)row * DM + col0 + bj * 128); }
#pragma unroll
            for (int m = 0; m < 4; ++m)
#pragma unroll
                for (int bj = 0; bj < 2; ++bj) { const int row = row0 + ai * 128 + m * 16; bf16_t* mp = Mg + (size_t)row * DM + col0 + bj * 128;
                    const u32x4 g4 = gv[m][bj], m4 = mv[m][bj]; float a[8];
                    a[0] = bflo(g4.x) * acc[ai][bj][m][0][0] + bflo(m4.x); a[1] = bfhi(g4.x) * acc[ai][bj][m][0][1] + bfhi(m4.x);
                    a[2] = bflo(g4.y) * acc[ai][bj][m][0][2] + bflo(m4.y); a[3] = bfhi(g4.y) * acc[ai][bj][m][0][3] + bfhi(m4.y);
                    a[4] = bflo(g4.z) * acc[ai][bj][m][1][0] + bflo(m4.z); a[5] = bfhi(g4.z) * acc[ai][bj][m][1][1] + bfhi(m4.z);
                    a[6] = bflo(g4.w) * acc[ai][bj][m][1][2] + bflo(m4.w); a[7] = bfhi(g4.w) * acc[ai][bj][m][1][3] + bfhi(m4.w);
                    u32x4 w; w.x = cvtpk(a[0], a[1]); w.y = cvtpk(a[2], a[3]); w.z = cvtpk(a[4], a[5]); w.w = cvtpk(a[6], a[7]);
                    *(u32x4*)mp = w; }
        }
    }
};

constexpr int MMAIN = 65536;
template <class TEpi> __device__ __forceinline__ void gemm_tail(LAS unsigned char* lds, const bf16_t* A_, const bf16_t* Bt_, int K_, const TEpi& E) {
    if (blockIdx.x >= 128) return;
    int tid = threadIdx.x; asm volatile("" : "+v"(tid));
    int K = K_; const bf16_t* A = A_; const bf16_t* Bt = Bt_; asm volatile("" : "+s"(K), "+s"(A), "+s"(Bt));
    const int lane = tid & 63, r32 = lane & 31, hi = lane >> 5; const int w = __builtin_amdgcn_readfirstlane(tid >> 6);
    const int rb = blockIdx.x >> 4, cbk = blockIdx.x & 15, row0 = MMAIN + rb * 32, col0 = cbk * 64;
    const int kchunk = K >> 3;
    const bf16_t* ap = A + (size_t)(row0 + r32) * K + w * kchunk + hi * 8;
    const bf16_t* bp0 = Bt + (size_t)(col0 + r32) * K + w * kchunk + hi * 8; const bf16_t* bp1 = bp0 + (size_t)32 * K;
    f32x16 c0, c1;
#pragma unroll
    for (int r = 0; r < 16; ++r) { c0[r] = 0.f; c1[r] = 0.f; }
    for (int k0 = 0; k0 < kchunk; k0 += 128) {
        const int nb = (kchunk - k0) >> 4; bf16x8 xa[8], w0[8], w1[8];
#pragma unroll
        for (int j = 0; j < 8; ++j) if (j < nb) { xa[j] = *(const bf16x8*)(ap + k0 + 16 * j); w0[j] = *(const bf16x8*)(bp0 + k0 + 16 * j); w1[j] = *(const bf16x8*)(bp1 + k0 + 16 * j); }
#pragma unroll
        for (int j = 0; j < 8; ++j) if (j < nb) { c0 = __builtin_amdgcn_mfma_f32_32x32x16_bf16(w0[j], xa[j], c0, 0, 0, 0); c1 = __builtin_amdgcn_mfma_f32_32x32x16_bf16(w1[j], xa[j], c1, 0, 0, 0); }
    }
    LAS float* Pp = (LAS float*)lds;
#pragma unroll
    for (int r = 0; r < 16; ++r) { Pp[((w * 2 + 0) * 16 + r) * 64 + lane] = c0[r]; Pp[((w * 2 + 1) * 16 + r) * 64 + lane] = c1[r]; }
    __syncthreads();
    const int a = w >> 2, g = w & 3; f32x4 v = {0.f, 0.f, 0.f, 0.f};
#pragma unroll
    for (int ww = 0; ww < 8; ++ww)
#pragma unroll
        for (int j = 0; j < 4; ++j) v[j] += Pp[((ww * 2 + a) * 16 + 4 * g + j) * 64 + lane];
    __syncthreads();
    E(row0 + r32, col0 + a * 32 + 8 * g + 4 * hi, v, cbk, w, lane, lds);
    __syncthreads();
}

template <class TEpi, bool SWI> __device__ __forceinline__ void gemm_tail2(LAS unsigned char* lds, const bf16_t* A_, const bf16_t* Bt_, int K_, int nitems_, const TEpi& E) {
    int tid = threadIdx.x; asm volatile("" : "+v"(tid));
    int K = K_, nitems = nitems_; const bf16_t* A = A_; const bf16_t* Bt = Bt_; asm volatile("" : "+s"(K), "+s"(A), "+s"(Bt), "+s"(nitems));
    const int lane = tid & 63, r32 = lane & 31, hi = lane >> 5; const int w = __builtin_amdgcn_readfirstlane(tid >> 6);
    const int kchunk = K >> 3;
    for (int item = blockIdx.x; item < nitems; item += gridDim.x) {
        const int rb = item & 7, cbk = item >> 3, row0 = MMAIN + rb * 32;
        const int brow0 = SWI ? (cbk >> 2) * 256 + (cbk & 3) * 32 : cbk * 64, brow1 = SWI ? brow0 + 128 : brow0 + 32;
        const bf16_t* ap = A + (size_t)(row0 + r32) * K + w * kchunk + hi * 8;
        const bf16_t* bp0 = Bt + (size_t)(brow0 + r32) * K + w * kchunk + hi * 8; const bf16_t* bp1 = Bt + (size_t)(brow1 + r32) * K + w * kchunk + hi * 8;
        f32x16 c0, c1;
#pragma unroll
        for (int r = 0; r < 16; ++r) { c0[r] = 0.f; c1[r] = 0.f; }
        for (int k0 = 0; k0 < kchunk; k0 += 128) {
            const int nb = (kchunk - k0) >> 4; bf16x8 xa[8], w0[8], w1[8];
#pragma unroll
            for (int j = 0; j < 8; ++j) if (j < nb) { xa[j] = *(const bf16x8*)(ap + k0 + 16 * j); w0[j] = *(const bf16x8*)(bp0 + k0 + 16 * j); w1[j] = *(const bf16x8*)(bp1 + k0 + 16 * j); }
#pragma unroll
            for (int j = 0; j < 8; ++j) if (j < nb) { c0 = __builtin_amdgcn_mfma_f32_32x32x16_bf16(w0[j], xa[j], c0, 0, 0, 0); c1 = __builtin_amdgcn_mfma_f32_32x32x16_bf16(w1[j], xa[j], c1, 0, 0, 0); }
        }
        LAS float* Pp = (LAS float*)lds;
#pragma unroll
        for (int r = 0; r < 16; ++r) { Pp[((w * 2 + 0) * 16 + r) * 64 + lane] = c0[r]; Pp[((w * 2 + 1) * 16 + r) * 64 + lane] = c1[r]; }
        __syncthreads();
        if (SWI) {
            if (w < 4) { f32x4 vg = {0.f, 0.f, 0.f, 0.f}, vu = {0.f, 0.f, 0.f, 0.f};
#pragma unroll
                for (int ww = 0; ww < 8; ++ww)
#pragma unroll
                    for (int j = 0; j < 4; ++j) { vg[j] += Pp[((ww * 2 + 0) * 16 + 4 * w + j) * 64 + lane]; vu[j] += Pp[((ww * 2 + 1) * 16 + 4 * w + j) * 64 + lane]; }
                E(row0 + r32, (cbk >> 2) * 128 + (cbk & 3) * 32 + 8 * w + 4 * hi, vg, vu); }
        } else {
            const int a = w >> 2, g = w & 3; f32x4 v = {0.f, 0.f, 0.f, 0.f};
#pragma unroll
            for (int ww = 0; ww < 8; ++ww)
#pragma unroll
                for (int j = 0; j < 4; ++j) v[j] += Pp[((ww * 2 + a) * 16 + 4 * g + j) * 64 + lane];
            E(row0 + r32, cbk * 64 + a * 32 + 8 * g + 4 * hi, v, v);
        }
        __syncthreads();
    }
}
template <int ACT> struct TEpiRow { bf16_t* O; int ldc; const float* ss;
    __device__ __forceinline__ void operator()(int row, int col, f32x4 v, f32x4) const { const float rs = rstd_of(ss, row);
        float a[4];
#pragma unroll
        for (int j = 0; j < 4; ++j) { const float x = v[j] * rs; a[j] = ACT ? sigm_f(x) : x; }
        u32x2 wv; wv.x = cvtpk(a[0], a[1]); wv.y = cvtpk(a[2], a[3]); *(u32x2*)(O + (size_t)row * ldc + col) = wv; }
};
struct TEpiSwi { bf16_t* O; const float* ss;
    __device__ __forceinline__ void operator()(int row, int col, f32x4 g, f32x4 u) const { const float rs = rstd_of(ss, row);
        float a[4];
#pragma unroll
        for (int j = 0; j < 4; ++j) a[j] = silu_f(g[j] * rs) * (u[j] * rs);
        u32x2 wv; wv.x = cvtpk(a[0], a[1]); wv.y = cvtpk(a[2], a[3]); *(u32x2*)(O + (size_t)row * DFF + col) = wv; }
};
struct TEpiRes { bf16_t* hb; float* ssn; float c;
    __device__ __forceinline__ void operator()(int row, int col, f32x4 v, int cbk, int w, int lane, LAS unsigned char* lds) const {
        bf16_t* bp = hb + (size_t)row * DM + col; const u32x2 h2 = *(const u32x2*)bp;
        f32x4 hv = {bflo(h2.x), bfhi(h2.x), bflo(h2.y), bfhi(h2.y)}; hv = hv + v * c;
        u32x2 wv; wv.x = cvtpk(hv[0], hv[1]); wv.y = cvtpk(hv[2], hv[3]); *(u32x2*)bp = wv;
        float q = (hv[0] * hv[0] + hv[1] * hv[1]) + (hv[2] * hv[2] + hv[3] * hv[3]); q += __shfl_xor(q, 32);
        LAS float* qb = (LAS float*)lds;
        if (lane < 32) qb[w * 32 + lane] = q;
        __syncthreads();
        if (w == 0 && lane < 32) { float t = 0.f;
#pragma unroll
            for (int ww = 0; ww < 8; ++ww) t += qb[ww * 32 + lane];
            ssn[(size_t)row * 16 + cbk] = t; }
    }
};
struct TEpiGate { bf16_t* Mg; const bf16_t* G; int gi; int first;
    __device__ __forceinline__ void operator()(int row, int col, f32x4 v, int cbk, int w, int lane, LAS unsigned char* lds) const {
        const u32x2 gv = *(const u32x2*)(G + (size_t)row * 3072 + gi * 1024 + col); bf16_t* mp = Mg + (size_t)row * DM + col;
        float a0 = bflo(gv.x) * v[0], a1 = bfhi(gv.x) * v[1], a2 = bflo(gv.y) * v[2], a3 = bfhi(gv.y) * v[3];
        if (!first) { const u32x2 mv = *(const u32x2*)mp; a0 += bflo(mv.x); a1 += bfhi(mv.x); a2 += bflo(mv.y); a3 += bfhi(mv.y); }
        u32x2 wv; wv.x = cvtpk(a0, a1); wv.y = cvtpk(a2, a3); *(u32x2*)mp = wv;
    }
};

constexpr int APITCH = 144, ASLOT = 64 * APITCH;
__device__ __forceinline__ int crow(int r, int hi) { return (r & 3) + 8 * (r >> 2) + 4 * hi; }
__device__ __forceinline__ s16x4 vtr(const LAS char* p) { return __builtin_bit_cast(s16x4, __builtin_amdgcn_ds_read_tr16_b64_v4i16((LAS s16x4*)p)); }
__device__ __forceinline__ int t5_bucket(int rel) {
    const int n = rel < 0 ? -rel : rel; int idx;
    if (n < 8) idx = n; else idx = 8 + (n >= 12) + (n >= 16) + (n >= 23) + (n >= 32) + (n >= 46) + (n >= 64) + (n >= 91);
    return idx + (rel > 0 ? 16 : 0);
}
__device__ __forceinline__ u32x4 pair16(u32x2 we, u32x2 wo) {
    const auto rx = __builtin_amdgcn_permlane32_swap(wo.x, we.x, false, false); const auto ry = __builtin_amdgcn_permlane32_swap(wo.y, we.y, false, false);
    return (u32x4){rx[0], ry[0], rx[1], ry[1]};
}
struct AttnP {
    const bf16_t* proj; bf16_t* ya; bf16_t* yb; bf16_t* yc;
    const float* t5; const float* rpb; const float* sink; const float* subg; const float* lq1; const float* lk1; const float* lq2; const float* lk2; int layer;
};
__device__ __forceinline__ float lam_init_of(int l) { return l == 0 ? 0.2f : l == 1 ? 0.355509068f : l == 2 ? 0.470713018f : 0.556058204f; }
template <int MODE> struct ACfg;
template <> struct ACfg<0> { static constexpr int NS = 4, ND = 4; };
template <> struct ACfg<1> { static constexpr int NS = 8, ND = 2; };
template <> struct ACfg<2> { static constexpr int NS = 2, ND = 2; };

template <int MODE> __device__ __forceinline__ void attn_unit(const AttnP& P, int u, LAS char* lds, bool fill) {
    constexpr int NS = ACfg<MODE>::NS, ND = ACfg<MODE>::ND;
    int tid = threadIdx.x; asm volatile("" : "+v"(tid));
    const int lane = tid & 63, r32 = lane & 31, hi = lane >> 5; const int w = __builtin_amdgcn_readfirstlane(tid >> 6);
    int b, x1, x2;
    if (MODE == 0) { b = u / (4 * 33); x1 = (u / 33) & 3; x2 = u % 33; }
    else { x1 = u / (NBATCH * 65); b = (u / 65) % NBATCH; x2 = u % 65; }
    int qtok0, qcol, kslot, head; bool metaunit = false;
    if (MODE == 0) { const int qs = w >> 1, mp = w & 1; head = x1; qtok0 = x2 * 128 + qs * 32; qcol = x1 * 128 + mp * 64; kslot = mp; }
    else if (MODE == 1) { const int hh = w >> 1, qs = w & 1; head = x1 * 4 + hh; metaunit = (x2 == 64); qtok0 = metaunit ? qs * 32 : NMETA + 64 * x2 + qs * 32; qcol = 1536 + head * 64; kslot = 2 * hh; }
    else { const int g = w >> 1, qs = w & 1; head = x1 * 4 + g; qtok0 = x2 * 64 + qs * 32; qcol = 3072 + head * 64; kslot = 0; }
    const int tq = qtok0 + r32;
    int nt, rs_ = 0, lo_ = 0;
    if (MODE == 0) nt = 65;
    else if (MODE == 1) { const int r = metaunit ? 0 : x2; rs_ = r - 4; rs_ = rs_ < 0 ? 0 : (rs_ > 56 ? 56 : rs_); nt = 9; }
    else { const int q0 = x2 * 64; lo_ = q0 - 128; if (lo_ < 0) lo_ = 0; int hiq = q0 + 192; if (hiq > LT) hiq = LT; nt = (hiq - lo_ + 63) / 64 + (lo_ > 0 ? 1 : 0); }
#define TILE_TOK0(t) (MODE == 0 ? 64 * (t) : MODE == 1 ? ((t) == 0 ? 0 : NMETA + 64 * (rs_ + (t) - 1)) : (lo_ > 0 ? ((t) == 0 ? 0 : lo_ + 64 * ((t) - 1)) : 64 * (t)))
#define STREAM_COL(s) (MODE == 0 ? ((s) < 2 ? 512 + x1 * 128 + (s) * 64 : 1024 + x1 * 128 + ((s) - 2) * 64) : MODE == 1 ? (((s) & 1) ? 2560 : 2048) + (x1 * 4 + ((s) >> 1)) * 64 : ((s) == 0 ? 3584 + x1 * 64 : 3712 + x1 * 64))
    LAS float* tab = (LAS float*)(lds + (MODE == 1 ? 98304 : MODE == 2 ? 110592 : NS * ASLOT));
    if (!fill) {} else
    if (MODE == 0) { for (int i = tid; i < 257; i += 512) tab[i] = P.t5[t5_bucket(i - 128) * 12 + x1] * LOG2E; }
    else if (MODE == 2) { for (int i = tid; i < 4 * 257; i += 512) { const int g = i / 257, j = i - g * 257; tab[i] = P.t5[t5_bucket(j - 128) * 12 + 4 + x1 * 4 + g] * LOG2E; }
        for (int i = tid; i < 4 * 384; i += 512) { const int g = i / 384, rel = i - g * 384 - 191; tab[4 * 257 + i] = (rel >= -128 && rel <= 128) ? P.t5[t5_bucket(rel) * 12 + 4 + x1 * 4 + g] * LOG2E : NEGV; } }
    else {
        for (int i = tid; i < 4 * 593 + 128; i += 512) { const int hh = i / 593, j = i - hh * 593 - 64; tab[i] = (i < 4 * 593 && j >= 0 && j < 465) ? P.rpb[(x1 * 4 + hh) * 465 + j] * LOG2E : 0.f; } }
    const LAS float* mytab = MODE == 0 ? tab : MODE == 2 ? tab + (w >> 1) * 257 : tab + (w >> 1) * 593 + 64;
    const LAS float* mytab2 = tab + 4 * 257 + (w >> 1) * 384;
    bf16x8 qr[4];
    { int qt = tq > LT - 1 ? LT - 1 : tq; const bf16_t* qp = P.proj + (size_t)(b * LT + qt) * INC + qcol + hi * 8;
#pragma unroll
      for (int ds = 0; ds < 4; ++ds) qr[ds] = *(const bf16x8*)(qp + ds * 16); }
    float mrun = NEGV, lrun = 0.f; f32x16 o[ND];
#pragma unroll
    for (int d = 0; d < ND; ++d)
#pragma unroll
        for (int r = 0; r < 16; ++r) o[d][r] = 0.f;
    const int lrow = tid >> 3, lch = tid & 7;
    u32x4 pre[NS];
    const bf16_t* pb = P.proj + (size_t)b * LT * INC + lch * 8;
#define ISSUE(t) do { int tok_ = TILE_TOK0(t) + lrow; tok_ = tok_ > LT - 1 ? LT - 1 : tok_; const bf16_t* src_ = pb + (size_t)tok_ * INC; \
        _Pragma("unroll") for (int s = 0; s < NS; ++s) pre[s] = *(const u32x4*)(src_ + STREAM_COL(s)); } while (0)
    ISSUE(0);
    int ccol = 0, cstart = 0;
    if (MODE == 1 && !metaunit) { ccol = (tq - NMETA) & 63; cstart = ccol - 8; cstart = cstart < 0 ? 0 : (cstart > 48 ? 48 : cstart); }
    float ng0[16], ng1[16];
    if (MODE == 1) {
#pragma unroll
        for (int r = 0; r < 16; ++r) { const int k0 = crow(r, hi), k1 = k0 + 32; ng0[r] = (k0 >= cstart && k0 < cstart + 16) ? 0.f : NEGV; ng1[r] = (k1 >= cstart && k1 < cstart + 16) ? 0.f : NEGV; }
    }
    const LAS char* kb = lds + kslot * ASLOT + r32 * APITCH + hi * 16;
    const int vrow = 4 * hi + ((lane & 15) >> 2), vcolb = 32 * ((lane >> 4) & 1) + 8 * (lane & 3);
    for (int t = 0; t < nt; ++t) {
        __syncthreads();
#pragma unroll
        for (int s = 0; s < NS; ++s) *(LAS u32x4*)(lds + s * ASLOT + lrow * APITCH + lch * 16) = pre[s];
        __syncthreads();
        if (t + 1 < nt) ISSUE(t + 1);
        const int tok0 = TILE_TOK0(t);
        f32x16 p0, p1;
#pragma unroll
        for (int r = 0; r < 16; ++r) { p0[r] = 0.f; p1[r] = 0.f; }
#pragma unroll
        for (int ds = 0; ds < 4; ++ds) {
            const bf16x8 k0 = *(const LAS bf16x8*)(kb + ds * 32);
            const bf16x8 k1 = *(const LAS bf16x8*)(kb + 32 * APITCH + ds * 32);
            p0 = __builtin_amdgcn_mfma_f32_32x32x16_bf16(k0, qr[ds], p0, 0, 0, 0);
            p1 = __builtin_amdgcn_mfma_f32_32x32x16_bf16(k1, qr[ds], p1, 0, 0, 0);
        }
        if (MODE == 0) {
            const bool farl = (tok0 + 63 + 128 <= qtok0), farr = (tok0 - (qtok0 + 31) >= 128) && (tok0 + 64 <= LT);
            if (farl || farr) { const float cb = farl ? mytab[0] : mytab[256];
#pragma unroll
                for (int r = 0; r < 16; ++r) { p0[r] += cb; p1[r] += cb; } }
            else {
#pragma unroll
                for (int r = 0; r < 16; ++r) { const int tk0 = tok0 + crow(r, hi), tk1 = tk0 + 32;
                    int i0 = tk0 - tq + 128; i0 = i0 < 0 ? 0 : (i0 > 256 ? 256 : i0); int i1 = tk1 - tq + 128; i1 = i1 < 0 ? 0 : (i1 > 256 ? 256 : i1);
                    p0[r] = tk0 < LT ? p0[r] + mytab[i0] : NEGV; p1[r] = tk1 < LT ? p1[r] + mytab[i1] : NEGV; } }
        } else if (MODE == 2) {
          if (tok0 >= NMETA && tok0 + 64 <= LT) {
            const LAS float* t2 = mytab2 + (tok0 - tq + 191 + 4 * hi);
#pragma unroll
            for (int r = 0; r < 16; ++r) { p0[r] += t2[(r & 3) + 8 * (r >> 2)]; p1[r] += t2[(r & 3) + 8 * (r >> 2) + 32]; }
          } else
#pragma unroll
            for (int r = 0; r < 16; ++r) { const int tk0 = tok0 + crow(r, hi), tk1 = tk0 + 32; const int r0 = tk0 - tq, r1 = tk1 - tq;
                int i0 = r0 + 128; i0 = i0 < 0 ? 0 : (i0 > 256 ? 256 : i0); int i1 = r1 + 128; i1 = i1 < 0 ? 0 : (i1 > 256 ? 256 : i1);
                const bool v0 = (tk0 < NMETA || (r0 >= -128 && r0 <= 128)) && tk0 < LT, v1 = (tk1 < NMETA || (r1 >= -128 && r1 <= 128)) && tk1 < LT;
                p0[r] = v0 ? p0[r] + mytab[i0] : NEGV; p1[r] = v1 ? p1[r] + mytab[i1] : NEGV; }
        } else {
            if (t == 0) {
#pragma unroll
                for (int r = 0; r < 16; ++r) { const int k0 = crow(r, hi); p0[r] = k0 < NMETA ? p0[r] : NEGV; p1[r] = NEGV; }
            } else {
                const int roff = (rs_ + t - 1) - x2 + 7;
                const LAS float* rt = metaunit ? tab + 4 * 593 + 4 * hi : mytab + roff * 31 + 15 - ccol + 4 * hi;
#pragma unroll
                for (int r = 0; r < 16; ++r) { p0[r] = p0[r] + rt[(r & 3) + 8 * (r >> 2)] + ng0[r]; p1[r] = p1[r] + rt[(r & 3) + 8 * (r >> 2) + 32] + ng1[r]; }
            }
        }
        float mx = fmaxf(fmaxf(p0[0], p0[1]), p1[0]);
#pragma unroll
        for (int r = 2; r < 16; r += 2) mx = fmaxf(fmaxf(mx, p0[r]), p0[r + 1]);
#pragma unroll
        for (int r = 1; r < 15; r += 2) mx = fmaxf(fmaxf(mx, p1[r]), p1[r + 1]);
        mx = fmaxf(mx, p1[15]);
        { const auto rr = __builtin_amdgcn_permlane32_swap(__float_as_uint(mx), __float_as_uint(mx), false, false); mx = fmaxf(__uint_as_float(rr[0]), __uint_as_float(rr[1])); }
        if (__any(mx > mrun + 8.0f)) {
            const float mnew = fmaxf(mrun, mx); const float f = __builtin_amdgcn_exp2f(mrun - mnew); mrun = mnew; lrun *= f;
#pragma unroll
            for (int d = 0; d < ND; ++d)
#pragma unroll
                for (int r = 0; r < 16; ++r) o[d][r] *= f;
        }
        float sacc = 0.f;
#pragma unroll
        for (int r = 0; r < 16; ++r) { p0[r] = __builtin_amdgcn_exp2f(p0[r] - mrun); p1[r] = __builtin_amdgcn_exp2f(p1[r] - mrun); sacc += p0[r] + p1[r]; }
        lrun += sacc;
        bf16x8 pf[4];
        { u32x4 a;
          a.x = cvtpk(p0[0], p0[1]); a.y = cvtpk(p0[2], p0[3]); a.z = cvtpk(p0[4], p0[5]); a.w = cvtpk(p0[6], p0[7]); pf[0] = __builtin_bit_cast(bf16x8, a);
          a.x = cvtpk(p0[8], p0[9]); a.y = cvtpk(p0[10], p0[11]); a.z = cvtpk(p0[12], p0[13]); a.w = cvtpk(p0[14], p0[15]); pf[1] = __builtin_bit_cast(bf16x8, a);
          a.x = cvtpk(p1[0], p1[1]); a.y = cvtpk(p1[2], p1[3]); a.z = cvtpk(p1[4], p1[5]); a.w = cvtpk(p1[6], p1[7]); pf[2] = __builtin_bit_cast(bf16x8, a);
          a.x = cvtpk(p1[8], p1[9]); a.y = cvtpk(p1[10], p1[11]); a.z = cvtpk(p1[12], p1[13]); a.w = cvtpk(p1[14], p1[15]); pf[3] = __builtin_bit_cast(bf16x8, a); }
#pragma unroll
        for (int d = 0; d < ND; ++d) {
            const int vslot = MODE == 0 ? 2 + (d >> 1) : MODE == 1 ? kslot + 1 : 1;
            const LAS char* vb = lds + vslot * ASLOT + vrow * APITCH + (d & 1) * 64 + vcolb;
#pragma unroll
            for (int ks = 0; ks < 4; ++ks) {
                const s16x4 vl = vtr(vb + (16 * ks) * APITCH), vh = vtr(vb + (16 * ks + 8) * APITCH);
                const bf16x8 vf = (bf16x8){vl[0], vl[1], vl[2], vl[3], vh[0], vh[1], vh[2], vh[3]};
                o[d] = __builtin_amdgcn_mfma_f32_32x32x16_bf16(vf, pf[ks], o[d], 0, 0, 0);
            }
        }
    }
    float ltot = lrun + __shfl_xor(lrun, 32);
    if (MODE == 2) ltot += __builtin_amdgcn_exp2f(P.sink[head] * LOG2E - mrun);
    const float inv = 1.0f / ltot;
    if (MODE == 0) {
        float a1 = P.lq1[lane] * P.lk1[lane], a2 = P.lq2[lane] * P.lk2[lane];
#pragma unroll
        for (int s = 1; s < 64; s <<= 1) { a1 += __shfl_xor(a1, s); a2 += __shfl_xor(a2, s); }
        const float lam = __expf(a1) - __expf(a2) + lam_init_of(P.layer);
        __syncthreads();
        LAS float* X = (LAS float*)lds;
        const int qs = w >> 1, mp = w & 1;
        if (mp == 1) {
#pragma unroll
            for (int d = 0; d < ND; ++d)
#pragma unroll
                for (int r = 0; r < 16; ++r) X[(qs * 128 + d * 32 + crow(r, hi)) * 32 + r32] = o[d][r] * inv;
        }
        __syncthreads();
        if (mp == 0) {
            float q = 0.f;
#pragma unroll
            for (int d = 0; d < ND; ++d)
#pragma unroll
                for (int r = 0; r < 16; ++r) { const float v = o[d][r] * inv - lam * X[(qs * 128 + d * 32 + crow(r, hi)) * 32 + r32]; o[d][r] = v; q += v * v; }
            q += __shfl_xor(q, 32);
            const float rn = rsqrtf(q * (1.0f / 128.0f) + EPS) * (1.0f - lam_init_of(P.layer));
            if (tq < LT) {
                bf16_t* op = P.ya + (size_t)(b * LT + tq) * 512 + x1 * 128;
#pragma unroll
                for (int d = 0; d < ND; ++d)
#pragma unroll
                    for (int r4 = 0; r4 < 4; ++r4) { const int dd = d * 32 + 8 * r4 + 4 * hi; const f32x4 gg = *(const f32x4*)(P.subg + dd);
                        u32x2 wv; wv.x = cvtpk(o[d][4 * r4] * rn * gg[0], o[d][4 * r4 + 1] * rn * gg[1]); wv.y = cvtpk(o[d][4 * r4 + 2] * rn * gg[2], o[d][4 * r4 + 3] * rn * gg[3]);
                        *(u32x2*)(op + dd) = wv; }
            }
        }
    } else {
        const bool qvalid = MODE == 1 ? (metaunit ? tq < NMETA : true) : (tq < LT);
        bf16_t* op = (MODE == 1 ? P.yb : P.yc) + (size_t)(b * LT + tq) * 512 + head * 64;
#pragma unroll
        for (int d = 0; d < ND; ++d)
#pragma unroll
            for (int rp = 0; rp < 2; ++rp) { u32x2 we, wo;
                we.x = cvtpk(o[d][8 * rp] * inv, o[d][8 * rp + 1] * inv); we.y = cvtpk(o[d][8 * rp + 2] * inv, o[d][8 * rp + 3] * inv);
                wo.x = cvtpk(o[d][8 * rp + 4] * inv, o[d][8 * rp + 5] * inv); wo.y = cvtpk(o[d][8 * rp + 6] * inv, o[d][8 * rp + 7] * inv);
                const u32x4 v = pair16(we, wo);
                if (qvalid) *(u32x4*)(op + d * 32 + 8 * (2 * rp + (hi ? 0 : 1))) = v; }
    }
    __syncthreads();
#undef TILE_TOK0
#undef STREAM_COL
#undef ISSUE
}

constexpr int AKP = 144, AVP = 192, AKS = 64 * AKP, AVS = 64 * AVP, ABUF = 2 * AKS + 2 * AVS, ATAB = 3 * ABUF;
__device__ __forceinline__ void attn_unit_A(const AttnP& P, int u, LAS char* lds) {
    int tid = threadIdx.x; asm volatile("" : "+v"(tid));
    const int lane = tid & 63, r32 = lane & 31, hi = lane >> 5; const int w = __builtin_amdgcn_readfirstlane(tid >> 6);
    const int b = u / (4 * 33), h = (u / 33) & 3, qb = u % 33;
    const int qs = w >> 1, mp = w & 1;
    const int qtok0 = qb * 128 + qs * 32, tq = qtok0 + r32;
    constexpr int nt = 65;
    LAS float* tab = (LAS float*)(lds + ATAB);
    for (int i = tid; i < 257; i += 512) tab[i] = P.t5[t5_bucket(i - 128) * 12 + h] * LOG2E;
    bf16x8 qr[4];
    { const int qt = tq > LT - 1 ? LT - 1 : tq; const bf16_t* qp = P.proj + (size_t)(b * LT + qt) * INC + h * 128 + mp * 64 + hi * 8;
#pragma unroll
      for (int ds = 0; ds < 4; ++ds) qr[ds] = *(const bf16x8*)(qp + ds * 16); }
    f32x16 o[4];
#pragma unroll
    for (int d = 0; d < 4; ++d)
#pragma unroll
        for (int r = 0; r < 16; ++r) o[d][r] = 0.f;
    const int lrow = tid >> 3, lch = tid & 7;
    u32x4 pre[4];
    const bf16_t* pb = P.proj + (size_t)b * LT * INC + lch * 8 + h * 128;
#define A_ISSUE(t) do { int tok_ = 64 * (t) + lrow; tok_ = tok_ > LT - 1 ? LT - 1 : tok_; const bf16_t* src_ = pb + (size_t)tok_ * INC; \
        pre[0] = *(const u32x4*)(src_ + 512); pre[1] = *(const u32x4*)(src_ + 576); pre[2] = *(const u32x4*)(src_ + 1024); pre[3] = *(const u32x4*)(src_ + 1088); } while (0)
#define A_WRITE(bufo) do { LAS char* d_ = lds + (bufo); \
        *(LAS u32x4*)(d_ + lrow * AKP + lch * 16) = pre[0]; *(LAS u32x4*)(d_ + AKS + lrow * AKP + lch * 16) = pre[1]; \
        *(LAS u32x4*)(d_ + 2 * AKS + lrow * AVP + lch * 16) = pre[2]; *(LAS u32x4*)(d_ + 2 * AKS + AVS + lrow * AVP + lch * 16) = pre[3]; } while (0)
#define A_BAR() asm volatile("s_waitcnt lgkmcnt(0)\n\ts_barrier" ::: "memory")
#define A_QK(S0, S1, bufo) do { const LAS char* kb_ = lds + (bufo) + mp * AKS + r32 * AKP + hi * 16; \
        _Pragma("unroll") for (int r = 0; r < 16; ++r) { S0[r] = 0.f; S1[r] = 0.f; } \
        _Pragma("unroll") for (int ds = 0; ds < 4; ++ds) { const bf16x8 k0_ = *(const LAS bf16x8*)(kb_ + ds * 32); const bf16x8 k1_ = *(const LAS bf16x8*)(kb_ + 32 * AKP + ds * 32); \
            S0 = __builtin_amdgcn_mfma_f32_32x32x16_bf16(k0_, qr[ds], S0, 0, 0, 0); S1 = __builtin_amdgcn_mfma_f32_32x32x16_bf16(k1_, qr[ds], S1, 0, 0, 0); } } while (0)
#define A_BIAS(S0, S1, t, cb) do { const int tok0_ = 64 * (t); \
        const bool farl_ = (tok0_ + 63 + 128 <= qtok0), farr_ = (tok0_ - (qtok0 + 31) >= 128) && (tok0_ + 64 <= LT); \
        if (farl_ || farr_) { cb = farl_ ? tab[0] : tab[256]; } \
        else { cb = 0.f; \
            _Pragma("unroll") for (int r = 0; r < 16; ++r) { const int tk0 = tok0_ + crow(r, hi), tk1 = tk0 + 32; \
                int i0 = tk0 - tq + 128; i0 = i0 < 0 ? 0 : (i0 > 256 ? 256 : i0); int i1 = tk1 - tq + 128; i1 = i1 < 0 ? 0 : (i1 > 256 ? 256 : i1); \
                S0[r] = tk0 < LT ? S0[r] + tab[i0] : NEGV; S1[r] = tk1 < LT ? S1[r] + tab[i1] : NEGV; } } \
        float mx_ = fmaxf(fmaxf(S0[0], S0[1]), S1[0]); \
        _Pragma("unroll") for (int r = 2; r < 16; r += 2) mx_ = fmaxf(fmaxf(mx_, S0[r]), S0[r + 1]); \
        _Pragma("unroll") for (int r = 1; r < 15; r += 2) mx_ = fmaxf(fmaxf(mx_, S1[r]), S1[r + 1]); \
        mx_ = fmaxf(mx_, S1[15]) + cb; mx_ = fmaxf(mx_, __shfl_xor(mx_, 32)); \
        if (__any(mx_ > mrun + 8.0f)) { const float mnew_ = fmaxf(mrun, mx_); const float f_ = __builtin_amdgcn_exp2f(mrun - mnew_); mrun = mnew_; lrun *= f_; \
            _Pragma("unroll") for (int d = 0; d < 4; ++d) _Pragma("unroll") for (int r = 0; r < 16; ++r) o[d][r] *= f_; } } while (0)
    float a1 = P.lq1[lane] * P.lk1[lane], a2 = P.lq2[lane] * P.lk2[lane];
#pragma unroll
    for (int s = 1; s < 64; s <<= 1) { a1 += __shfl_xor(a1, s); a2 += __shfl_xor(a2, s); }
    unsigned lamu = __builtin_amdgcn_readfirstlane(__float_as_uint(__expf(a1) - __expf(a2) + lam_init_of(P.layer))); asm volatile("" : "+s"(lamu));
    const float lam = __uint_as_float(lamu);
    A_ISSUE(0);
    __syncthreads();
    A_WRITE(0); A_ISSUE(1);
    A_BAR();
    f32x16 sa0, sa1, negc; float lrun = 0.f;
    const int vrow = 4 * hi + ((lane & 15) >> 2), vcolb = 32 * ((lane >> 4) & 1) + 8 * (lane & 3);
    int clsk;
#define A_CLS(t) (((64 * (t)) + 63 + 128 <= qtok0) ? 0 : ((((64 * (t)) - (qtok0 + 31) >= 128) && ((64 * (t)) + 64 <= LT)) ? 2 : 1))
#define A_CVAL(c) ((c) == 0 ? tab[0] : (c) == 2 ? tab[256] : 0.f)
#define A_NEAR(S0, S1, t) do { const int tok0_ = 64 * (t); \
        _Pragma("unroll") for (int r = 0; r < 16; ++r) { const int tk0 = tok0_ + crow(r, hi), tk1 = tk0 + 32; \
            int i0 = tk0 - tq + 128; i0 = i0 < 0 ? 0 : (i0 > 256 ? 256 : i0); int i1 = tk1 - tq + 128; i1 = i1 < 0 ? 0 : (i1 > 256 ? 256 : i1); \
            S0[r] = tk0 < LT ? S0[r] + tab[i0] : NEGV; S1[r] = tk1 < LT ? S1[r] + tab[i1] : NEGV; } } while (0)
#define A_ROWMAX(S0, S1, mx_) do { mx_ = fmaxf(fmaxf(S0[0], S0[1]), S1[0]); \
        _Pragma("unroll") for (int r = 2; r < 16; r += 2) mx_ = fmaxf(fmaxf(mx_, S0[r]), S0[r + 1]); \
        _Pragma("unroll") for (int r = 1; r < 15; r += 2) mx_ = fmaxf(fmaxf(mx_, S1[r]), S1[r + 1]); \
        mx_ = fmaxf(mx_, S1[15]); { const auto rr_ = __builtin_amdgcn_permlane32_swap(__float_as_uint(mx_), __float_as_uint(mx_), false, false); mx_ = fmaxf(__uint_as_float(rr_[0]), __uint_as_float(rr_[1])); } } while (0)
    {
        A_QK(sa0, sa1, 0);
        clsk = A_CLS(0);
        if (clsk == 1) A_NEAR(sa0, sa1, 0);
        else { const float c0 = A_CVAL(clsk);
#pragma unroll
            for (int r = 0; r < 16; ++r) { sa0[r] += c0; sa1[r] += c0; } }
        float mx0; A_ROWMAX(sa0, sa1, mx0);
        const float nc = A_CVAL(clsk) - mx0;
#pragma unroll
        for (int r = 0; r < 16; ++r) { sa0[r] -= mx0; sa1[r] -= mx0; negc[r] = nc; }
    }
    int bcur = 0, bnext = ABUF;
    for (int t = 0; t < nt; ++t) {
        const bool more = (t + 1 < nt);
        if (more) { A_WRITE(bnext); if (t + 2 < nt) A_ISSUE(t + 2); }
        int clsn = clsk;
        if (more) { clsn = A_CLS(t + 1);
            if (clsn != clsk) { const float dc = A_CVAL(clsn) - A_CVAL(clsk); clsk = clsn;
#pragma unroll
                for (int r = 0; r < 16; ++r) negc[r] += dc; } }
#define A_QKBLK() do { const LAS char* kb_ = lds + bnext + mp * AKS + r32 * AKP + hi * 16; bf16x8 kf[8]; \
        _Pragma("unroll") for (int ds = 0; ds < 4; ++ds) { kf[2 * ds] = *(const LAS bf16x8*)(kb_ + ds * 32); kf[2 * ds + 1] = *(const LAS bf16x8*)(kb_ + 32 * AKP + ds * 32); } \
        sa0 = __builtin_amdgcn_mfma_f32_32x32x16_bf16(kf[0], qr[0], negc, 0, 0, 0); sa1 = __builtin_amdgcn_mfma_f32_32x32x16_bf16(kf[1], qr[0], negc, 0, 0, 0); \
        _Pragma("unroll") for (int ds = 1; ds < 4; ++ds) { sa0 = __builtin_amdgcn_mfma_f32_32x32x16_bf16(kf[2 * ds], qr[ds], sa0, 0, 0, 0); sa1 = __builtin_amdgcn_mfma_f32_32x32x16_bf16(kf[2 * ds + 1], qr[ds], sa1, 0, 0, 0); } } while (0)
        const LAS char* vbase = lds + bcur + 2 * AKS + vrow * AVP + vcolb;
#define A_VLOAD(dst, d) do { const LAS char* vb_ = vbase + ((d) >> 1) * AVS + ((d) & 1) * 64; \
        _Pragma("unroll") for (int ks = 0; ks < 4; ++ks) { const s16x4 vl_ = vtr(vb_ + (16 * ks) * AVP), vh_ = vtr(vb_ + (16 * ks + 8) * AVP); \
            dst[ks] = (bf16x8){vl_[0], vl_[1], vl_[2], vl_[3], vh_[0], vh_[1], vh_[2], vh_[3]}; } } while (0)
#define A_VMMA(src, d) do { _Pragma("unroll") for (int ks = 0; ks < 4; ++ks) o[d] = __builtin_amdgcn_mfma_f32_32x32x16_bf16(src[ks], pf[ks], o[d], 0, 0, 0); } while (0)
        bf16x8 vfa[4], vfb[4];
        A_VLOAD(vfa, 0);
        __builtin_amdgcn_sched_barrier(0);
        float sacc = 0.f;
#pragma unroll
        for (int r = 0; r < 16; ++r) { sa0[r] = __builtin_amdgcn_exp2f(sa0[r]); sa1[r] = __builtin_amdgcn_exp2f(sa1[r]); sacc += sa0[r] + sa1[r]; }
        lrun += sacc;
        bf16x8 pf[4];
        { u32x4 a;
          a.x = cvtpk(sa0[0], sa0[1]); a.y = cvtpk(sa0[2], sa0[3]); a.z = cvtpk(sa0[4], sa0[5]); a.w = cvtpk(sa0[6], sa0[7]); pf[0] = __builtin_bit_cast(bf16x8, a);
          a.x = cvtpk(sa0[8], sa0[9]); a.y = cvtpk(sa0[10], sa0[11]); a.z = cvtpk(sa0[12], sa0[13]); a.w = cvtpk(sa0[14], sa0[15]); pf[1] = __builtin_bit_cast(bf16x8, a);
          a.x = cvtpk(sa1[0], sa1[1]); a.y = cvtpk(sa1[2], sa1[3]); a.z = cvtpk(sa1[4], sa1[5]); a.w = cvtpk(sa1[6], sa1[7]); pf[2] = __builtin_bit_cast(bf16x8, a);
          a.x = cvtpk(sa1[8], sa1[9]); a.y = cvtpk(sa1[10], sa1[11]); a.z = cvtpk(sa1[12], sa1[13]); a.w = cvtpk(sa1[14], sa1[15]); pf[3] = __builtin_bit_cast(bf16x8, a); }
        __builtin_amdgcn_sched_barrier(0);
        A_VLOAD(vfb, 1);
        __builtin_amdgcn_sched_barrier(0);
        A_VMMA(vfa, 0);
        A_VLOAD(vfa, 2);
        __builtin_amdgcn_sched_barrier(0);
        A_VMMA(vfb, 1);
        A_VLOAD(vfb, 3);
        __builtin_amdgcn_sched_barrier(0);
        A_VMMA(vfa, 2);
        __builtin_amdgcn_sched_barrier(0);
        A_VMMA(vfb, 3);
#undef A_VLOAD
#undef A_VMMA
        __builtin_amdgcn_sched_barrier(0); A_BAR(); A_QKBLK();
#undef A_QKBLK
        if (more) {
            if (clsn == 1) A_NEAR(sa0, sa1, t + 1);
            float mx_; A_ROWMAX(sa0, sa1, mx_);
            if (__any(mx_ > 8.0f)) { const float dl = fmaxf(mx_, 0.f); const float f_ = __builtin_amdgcn_exp2f(-dl); lrun *= f_;
#pragma unroll
                for (int r = 0; r < 16; ++r) { sa0[r] -= dl; sa1[r] -= dl; negc[r] -= dl; }
#pragma unroll
                for (int d = 0; d < 4; ++d)
#pragma unroll
                    for (int r = 0; r < 16; ++r) o[d][r] *= f_; }
        }
        bcur = bnext; bnext = bnext + ABUF; if (bnext == 3 * ABUF) bnext = 0;
    }
#undef A_CLS
#undef A_CVAL
#undef A_NEAR
#undef A_ROWMAX
    const float inv = 1.0f / (lrun + __shfl_xor(lrun, 32));
    __syncthreads();
    LAS float* X = (LAS float*)lds;
    if (mp == 1) {
#pragma unroll
        for (int d = 0; d < 4; ++d)
#pragma unroll
            for (int r = 0; r < 16; ++r) X[(qs * 128 + d * 32 + crow(r, hi)) * 32 + r32] = o[d][r] * inv;
    }
    __syncthreads();
    if (mp == 0) {
        float q = 0.f;
#pragma unroll
        for (int d = 0; d < 4; ++d)
#pragma unroll
            for (int r = 0; r < 16; ++r) { const float v = o[d][r] * inv - lam * X[(qs * 128 + d * 32 + crow(r, hi)) * 32 + r32]; o[d][r] = v; q += v * v; }
        q += __shfl_xor(q, 32);
        int ly = P.layer; asm volatile("" : "+s"(ly));
        const float rn = rsqrtf(q * (1.0f / 128.0f) + EPS) * (1.0f - lam_init_of(ly));
        { bf16_t* op = P.ya + (size_t)(b * LT + tq) * 512 + h * 128; const bool qok = tq < LT;
#pragma unroll
            for (int d = 0; d < 4; ++d)
#pragma unroll
                for (int rp = 0; rp < 2; ++rp) { u32x2 w2[2];
#pragma unroll
                    for (int k = 0; k < 2; ++k) { const int r4 = 2 * rp + k, dd = d * 32 + 8 * r4 + 4 * hi; const f32x4 gg = *(const f32x4*)(P.subg + dd);
                        w2[k].x = cvtpk(o[d][4 * r4] * rn * gg[0], o[d][4 * r4 + 1] * rn * gg[1]); w2[k].y = cvtpk(o[d][4 * r4 + 2] * rn * gg[2], o[d][4 * r4 + 3] * rn * gg[3]); }
                    const u32x4 v = pair16(w2[0], w2[1]);
                    if (qok) *(u32x4*)(op + d * 32 + 8 * (2 * rp + (hi ? 0 : 1))) = v; }
        }
    }
    __syncthreads();
#undef A_ISSUE
#undef A_WRITE
#undef A_BAR
#undef A_QK
#undef A_BIAS
}
constexpr int NUA = NBATCH * 4 * 33, NUB = NBATCH * 2 * 65, NUC = NBATCH * 2 * 65;

__device__ __forceinline__ void conv_item(const float* W, int Nsrc, int K, int k0, int scol, bf16_t* WT, int drow, const float* gain, float cscale, LAS float* scr, int lane) {
#pragma unroll 8
    for (int i = 0; i < 32; ++i) { const int kk = 2 * i + (lane >> 5); const float gg = gain ? gain[k0 + kk] * cscale : cscale;
        scr[kk * 33 + (lane & 31)] = W[(size_t)(k0 + kk) * Nsrc + scol + (lane & 31)] * gg; }
    asm volatile("s_waitcnt lgkmcnt(0)" ::: "memory");
    const int c = lane & 7;
#pragma unroll
    for (int j = 0; j < 4; ++j) { const int n = (lane >> 3) + 8 * j; const LAS float* s = scr + (8 * c) * 33 + n;
        u32x4 o; o.x = cvtpk(s[0 * 33], s[1 * 33]); o.y = cvtpk(s[2 * 33], s[3 * 33]); o.z = cvtpk(s[4 * 33], s[5 * 33]); o.w = cvtpk(s[6 * 33], s[7 * 33]);
        *(u32x4*)(WT + (size_t)(drow + n) * K + k0 + 8 * c) = o; }
    asm volatile("s_waitcnt lgkmcnt(0)" ::: "memory");
}


#define XB_TMO      128
#define XB_XCNT(j)  (256  + 64 * (j))
#define XB_XSUB(j)  (1280 + 64 * (j))
#define XB_XGEN(j)  (2304 + 64 * (j))
#define XB_TOP      3328
#define XB_TOPGEN   3392
#define XCD_BAR_WORDS 3456
#define XB_SPIN_CAP (1u << 22)
__device__ __forceinline__ unsigned xb_ld(unsigned* p)              { return __hip_atomic_load(p, __ATOMIC_RELAXED, __HIP_MEMORY_SCOPE_AGENT); }
__device__ __forceinline__ unsigned xb_add(unsigned* p, unsigned v) { return __hip_atomic_fetch_add(p, v, __ATOMIC_RELAXED, __HIP_MEMORY_SCOPE_AGENT); }
__device__ __forceinline__ unsigned xb_xcc_id() { return (unsigned)__builtin_amdgcn_s_getreg((3 << 11) | 20) & 0xFu; }
#define XB_SPIN(cond, bar) do { unsigned _sp = 0; while (cond) { __builtin_amdgcn_s_sleep(1); \
    if ((++_sp & 255u) == 0u) { if (xb_ld(&(bar)[XB_TMO])) break; if (_sp > XB_SPIN_CAP) { atomicAdd(&(bar)[XB_TMO], 1u); break; } } } } while (0)
struct XcdBarrier { unsigned* bar; unsigned x; volatile LAS unsigned* st; };
__device__ __forceinline__ XcdBarrier xcd_barrier_post(unsigned* bar, volatile LAS unsigned* st) {
    XcdBarrier b; b.bar = bar; b.x = xb_xcc_id(); b.st = st;
    if (threadIdx.x == 0) (void)xb_add(&bar[XB_XCNT(b.x)], 1u);
    return b;
}
__device__ __forceinline__ void xcd_barrier_complete(unsigned* bar, unsigned x, unsigned& nloc, unsigned& nx) {
    const unsigned G = gridDim.x * gridDim.y * gridDim.z;
    unsigned sum, cnt, mine, sp = 0u;
    for (;;) {
        sum = 0u; cnt = 0u; mine = 0u;
#pragma unroll
        for (unsigned j = 0; j < 16; ++j) { const unsigned c = xb_ld(&bar[XB_XCNT(j)]); sum += c; cnt += (c > 0u) ? 1u : 0u; mine = (j == x) ? c : mine; }
        if (sum == G) break;
        __builtin_amdgcn_s_sleep(1);
        if ((++sp & 255u) == 0u) { if (xb_ld(&bar[XB_TMO])) break; if (sp > XB_SPIN_CAP) { atomicAdd(&bar[XB_TMO], 1u); break; } }
    }
    nloc = mine > 0u ? mine : 1u; nx = cnt > 0u ? cnt : 1u;
}
__device__ __forceinline__ void xcd_barrier(const XcdBarrier& b) {
    asm volatile("s_waitcnt vmcnt(0)" ::: "memory");
    __syncthreads();
    if (threadIdx.x == 0) {
        unsigned* bar = b.bar;
        __builtin_amdgcn_s_waitcnt(0);
        unsigned nloc = b.st[0], nx = b.st[1];
        if (nloc == 0u) { xcd_barrier_complete(bar, b.x, nloc, nx); b.st[0] = nloc; b.st[1] = nx; }
        const unsigned old = xb_add(&bar[XB_XSUB(b.x)], 1u);
        const unsigned gen = old / nloc;
        if (old + 1u == (gen + 1u) * nloc) {
            __builtin_amdgcn_fence(__ATOMIC_RELEASE, "agent");
            asm volatile("s_waitcnt vmcnt(0)" ::: "memory");
            const unsigned og = xb_add(&bar[XB_TOP], 1u);
            const unsigned tg = og / nx;
            if (og + 1u == (tg + 1u) * nx) xb_add(&bar[XB_TOPGEN], 1u);
            else XB_SPIN(xb_ld(&bar[XB_TOPGEN]) == tg, bar);
            __builtin_amdgcn_fence(__ATOMIC_ACQUIRE, "agent");
            xb_add(&bar[XB_XGEN(b.x)], 1u);
            asm volatile("s_waitcnt vmcnt(0)" ::: "memory");
        } else {
            XB_SPIN(xb_ld(&bar[XB_XGEN(b.x)]) == gen, bar);
            __builtin_amdgcn_fence(__ATOMIC_ACQUIRE, "agent");
            asm volatile("s_waitcnt vmcnt(0)" ::: "memory");
        }
    }
    __syncthreads();
}
constexpr size_t OFF_BAR = 8 * MiB + 512 * 1024;
constexpr int MISC_OFF = 135168;

struct Args {
    const float* x; const float* meta; const float* t5; const float* norm_ffn1; const float* w_ffn1_in; const float* w_ffn1_out; const float* norm_mix; const float* w_in;
    const float* lq1; const float* lk1; const float* lq2; const float* lk2; const float* subg; const float* rpb; const float* sink;
    const float* w_branch; const float* w_gate; const float* w_out; const float* norm_ffn2; const float* w_ffn2_in; const float* w_ffn2_out; const float* final_norm;
    float* out; unsigned char* ws;
};

constexpr int LDS_BYTES = 136 * 1024;
#ifndef ATT_REPS
#define ATT_REPS 1
#endif

__device__ __forceinline__ void conv_layer(const Args& a, int l, bf16_t* WB, LAS unsigned char* lds, int ngw) {
    int tid = threadIdx.x; asm volatile("" : "+v"(tid));
    const int lane = tid & 63, wave = __builtin_amdgcn_readfirstlane(tid >> 6), gw = blockIdx.x * 8 + wave;
    LAS float* scr = (LAS float*)(lds + wave * 16384);
    constexpr int I1 = 16 * 176, I2 = 44 * 32, I3 = 16 * 120, I4 = 3 * 16 * 32, I5 = 3 * 8 * 32, I6 = 16 * 32;
    constexpr int NIT = I1 + I2 + I3 + I4 + I5 + I6 + I1 + I2;
    for (int it = gw; it < NIT; it += ngw) {
        int r = it;
        if (r < I1 || (r >= I1 + I2 + I3 + I4 + I5 + I6 && r < I1 + I2 + I3 + I4 + I5 + I6 + I1)) {
            const bool second = r >= I1; if (second) r -= I1 + I2 + I3 + I4 + I5 + I6;
            const int kb = r / 176, db = r % 176, pn = db >> 3, o8 = db & 7; const int scol = (o8 >> 2) * DFF + 128 * pn + (o8 & 3) * 32;
            conv_item((second ? a.w_ffn2_in : a.w_ffn1_in) + (size_t)l * 1024 * 5632, 5632, 1024, kb * 64, scol, WB + (second ? WO_W3 : WO_W1), db * 32, (second ? a.norm_ffn2 : a.norm_ffn1) + l * 1024, 1.f, scr, lane);
            continue; }
        r -= I1;
        if (r < I2 || r >= I2 + I3 + I4 + I5 + I6 + I1) {
            const bool second = r >= I2; if (second) r -= I2 + I3 + I4 + I5 + I6 + I1;
            const int kb = r / 32, db = r % 32;
            conv_item((second ? a.w_ffn2_out : a.w_ffn1_out) + (size_t)l * 2816 * 1024, 1024, 2816, kb * 64, db * 32, WB + (second ? WO_W4 : WO_W2), db * 32, nullptr, 1.f, scr, lane);
            continue; }
        r -= I2;
        if (r < I3) { const int kb = r / 120, db = r % 120, col = db * 32;
            const bool isq = col < 512 || (col >= 1536 && col < 2048) || (col >= 3072 && col < 3584);
            conv_item(a.w_in + (size_t)l * 1024 * INC, INC, 1024, kb * 64, col, WB + WO_WIN, col, a.norm_mix + l * 1024, isq ? 0.125f * LOG2E : 1.f, scr, lane);
            continue; }
        r -= I3;
        if (r < I4) { const int gi = r / 512, rr = r % 512, kb = rr / 32, db = rr % 32;
            conv_item(a.w_gate + ((size_t)l * 3 + gi) * 1024 * 1024, 1024, 1024, kb * 64, db * 32, WB + WO_WG, gi * 1024 + db * 32, a.norm_mix + l * 1024, 1.f, scr, lane);
            continue; }
        r -= I4;
        if (r < I5) { const int gi = r / 256, rr = r % 256, kb = rr / 32, db = rr % 32;
            conv_item(a.w_branch + ((size_t)l * 3 + gi) * 512 * 1024, 1024, 512, kb * 64, db * 32, WB + WO_WB + (size_t)gi * 1024 * 512, db * 32, nullptr, 1.f, scr, lane);
            continue; }
        r -= I5;
        { const int kb = r / 32, db = r % 32;
          conv_item(a.w_out + (size_t)l * 1024 * 1024, 1024, 1024, kb * 64, db * 32, WB + WO_WO, db * 32, nullptr, 1.f, scr, lane); }
    }
}

#define GSYNC0() do { asm volatile("s_waitcnt vmcnt(0) lgkmcnt(0)" ::: "memory"); __builtin_amdgcn_fence(__ATOMIC_RELEASE, "agent"); grid.sync(); __builtin_amdgcn_fence(__ATOMIC_ACQUIRE, "agent"); } while (0)
__global__ void __launch_bounds__(512, 2) fwd_kernel(Args a) {
    extern __shared__ __attribute__((aligned(16))) unsigned char lds_raw[];
    LAS unsigned char* lds = (LAS unsigned char*)lds_raw;
    cg::grid_group grid = cg::this_grid();
    { volatile LAS unsigned* misc = (volatile LAS unsigned*)(lds + MISC_OFF); if (threadIdx.x < 2) misc[threadIdx.x] = 0u; __syncthreads(); }
    XcdBarrier xbar = xcd_barrier_post((unsigned*)(a.ws + OFF_BAR), (volatile LAS unsigned*)(lds + MISC_OFF));
#define XSYNC() xcd_barrier(xbar)
    const int G = gridDim.x, ngw = G * 8;
    float* SS = (float*)(a.ws + OFF_SS); bf16_t* HB = (bf16_t*)(a.ws + OFF_HB); bf16_t* WB = (bf16_t*)(a.ws + OFF_W);
    bf16_t* Y = (bf16_t*)(a.ws + OFF_Y); bf16_t* MG = (bf16_t*)(a.ws + OFF_MG); bf16_t* R = (bf16_t*)(a.ws + OFF_R);
    bf16_t* YA = Y; bf16_t* YB = Y + (size_t)MROWS * 512; bf16_t* YC = Y + (size_t)2 * MROWS * 512;

    { int tid1 = threadIdx.x; asm volatile("" : "+v"(tid1)); const int lane = tid1 & 63, gw = blockIdx.x * 8 + __builtin_amdgcn_readfirstlane(tid1 >> 6);
    for (int row = gw; row < MROWS; row += ngw) {
        const int b = row / LT, t = row - b * LT;
        const float* src = t < NMETA ? a.meta + (size_t)t * DM : a.x + ((size_t)b * SEQ + (t - NMETA)) * DM;
        bf16_t* hb = HB + (size_t)row * DM; float q = 0.f;
#pragma unroll
        for (int j = 0; j < 4; ++j) { const f32x4 v = *(const f32x4*)(src + j * 256 + lane * 4);
            q += (v[0] * v[0] + v[1] * v[1]) + (v[2] * v[2] + v[3] * v[3]); u32x2 wv; wv.x = cvtpk(v[0], v[1]); wv.y = cvtpk(v[2], v[3]); *(u32x2*)(hb + j * 256 + lane * 4) = wv; }
#pragma unroll
        for (int s = 1; s < 64; s <<= 1) q += __shfl_xor(q, s);
        if (lane < 16) SS[(size_t)row * 16 + lane] = lane == 0 ? q : 0.f;
    } }

    for (int l = 0; l < DEPTH; ++l) {
        conv_layer(a, l, WB, lds, ngw);
        if (gridDim.x == 0) GSYNC0();
        XSYNC();
        constexpr size_t SSB = (size_t)MROWS * 16; const float* ss0 = SS + ((3 * l) & 1) * SSB; float* ss1 = SS + ((3 * l + 1) & 1) * SSB; float* ss2 = SS + ((3 * l + 2) & 1) * SSB; float* ss3 = SS + ((3 * l + 3) & 1) * SSB;
        pg8::StaticOrder S;
        { pg8::Gemm g{HB, WB + WO_W1, MMAIN, 5632, 1024}; S.init(MMAIN, 5632, G, blockIdx.x); EpiSwiGLU E{R, ss0}; pg8::gemm_phase(lds, g, S, E);
          TEpiSwi TE{R, ss0}; gemm_tail2<TEpiSwi, true>(lds, HB, WB + WO_W1, 1024, 8 * 88, TE); }
        XSYNC();
        { pg8::Gemm g{R, WB + WO_W2, MMAIN, 1024, DFF}; S.init(MMAIN, 1024, G, blockIdx.x); EpiRes E{HB, ss1, 0.5f}; pg8::gemm_phase(lds, g, S, E);
          TEpiRes TE{HB, ss1, 0.5f}; gemm_tail(lds, R, WB + WO_W2, DFF, TE); }
        XSYNC();
        { pg8::Gemm g{HB, WB + WO_WIN, MMAIN, INC, 1024}; S.init(MMAIN, INC, G, blockIdx.x); EpiRow<0> E{R, INC, ss1}; pg8::gemm_phase(lds, g, S, E);
          TEpiRow<0> TE{R, INC, ss1}; gemm_tail2<TEpiRow<0>, false>(lds, HB, WB + WO_WIN, 1024, 8 * 60, TE); }
        XSYNC();
        {
          AttnP P{R, YA, YB, YC, a.t5, a.rpb + (size_t)l * 8 * 465, a.sink + l * 8, a.subg + l * 128, a.lq1 + l * 64, a.lk1 + l * 64, a.lq2 + l * 64, a.lk2 + l * 64,
                  l};
          for (int rep = 0; rep < ATT_REPS; ++rep) {
          if (G == 256) { const int x = blockIdx.x & 7, jx = blockIdx.x >> 3;
              for (int r = 0; r < 8; ++r) attn_unit_A(P, (x + 8 * r) * 33 + jx, (LAS char*)lds);
              if (jx < 8) attn_unit_A(P, (x + 8 * jx) * 33 + 32, (LAS char*)lds);
          } else { for (int u = blockIdx.x; u < NUA; u += G) attn_unit_A(P, u, (LAS char*)lds); }
          constexpr int NBC = NUB + NUC, N1 = 12, NLOW = 64 * N1;
          const int wg = blockIdx.x;
          int keyB = -1, keyC = -1;
#define RUN_BC(j) do { const int u_ = (j) >> 1, k_ = u_ / (NBATCH * 65); if ((j) & 1) { attn_unit<2>(P, u_, (LAS char*)lds, k_ != keyC); keyC = k_; } else { attn_unit<1>(P, u_, (LAS char*)lds, k_ != keyB); keyB = k_; } } while (0)
          if (G == 256) {
              if (wg < 64) { for (int j = (wg & 7) * 8 + (wg >> 3); j < NLOW; j += 64) RUN_BC(j); }
              else { for (int j = NLOW + (wg & 7) * 24 + ((wg - 64) >> 3); j < NBC; j += 192) RUN_BC(j); }
          } else { for (int j = wg; j < NBC; j += G) RUN_BC(j); }
#undef RUN_BC
          } }
        XSYNC();
        { pg8::Gemm g{HB, WB + WO_WG, MMAIN, 3072, 1024}; S.init(MMAIN, 3072, G, blockIdx.x); EpiRow<1> E{R, 3072, ss1}; pg8::gemm_phase(lds, g, S, E);
          TEpiRow<1> TE{R, 3072, ss1}; gemm_tail2<TEpiRow<1>, false>(lds, HB, WB + WO_WG, 1024, 8 * 48, TE); }
        XSYNC();
        { pg8::Gemm g{Y, WB + WO_WB, MMAIN, 1024, 512}; pg8::BranchOrder BS; BS.S.init(MMAIN, 1024, G, blockIdx.x);
          EpiGate E{MG, R}; pg8::gemm_phase(lds, g, BS, E);
          __syncthreads();
          for (int gi = 0; gi < 3; ++gi) { TEpiGate TE{MG, R, gi, gi == 0}; gemm_tail(lds, Y + (size_t)gi * MROWS * 512, WB + WO_WB + (size_t)gi * 1024 * 512, 512, TE); } }
        XSYNC();
        { pg8::Gemm g{MG, WB + WO_WO, MMAIN, 1024, 1024}; S.init(MMAIN, 1024, G, blockIdx.x); EpiRes E{HB, ss2, 1.0f}; pg8::gemm_phase(lds, g, S, E);
          TEpiRes TE{HB, ss2, 1.0f}; gemm_tail(lds, MG, WB + WO_WO, 1024, TE); }
        XSYNC();
        { pg8::Gemm g{HB, WB + WO_W3, MMAIN, 5632, 1024}; S.init(MMAIN, 5632, G, blockIdx.x); EpiSwiGLU E{R, ss2}; pg8::gemm_phase(lds, g, S, E);
          TEpiSwi TE{R, ss2}; gemm_tail2<TEpiSwi, true>(lds, HB, WB + WO_W3, 1024, 8 * 88, TE); }
        XSYNC();
        { pg8::Gemm g{R, WB + WO_W4, MMAIN, 1024, DFF}; S.init(MMAIN, 1024, G, blockIdx.x); EpiRes E{HB, ss3, 0.5f}; pg8::gemm_phase(lds, g, S, E);
          TEpiRes TE{HB, ss3, 0.5f}; gemm_tail(lds, R, WB + WO_W4, DFF, TE); }
        XSYNC();
    }
    { const float* ssf = SS; int tid2 = threadIdx.x; asm volatile("" : "+v"(tid2)); const int lane = tid2 & 63, gw = blockIdx.x * 8 + __builtin_amdgcn_readfirstlane(tid2 >> 6);
      for (int row = gw; row < NBATCH * SEQ; row += ngw) { const int b = row / SEQ, sq = row - b * SEQ, m = b * LT + NMETA + sq; const float rs = rstd_of(ssf, m);
          const bf16_t* hp = HB + (size_t)m * DM; float* p = a.out + (size_t)row * DM;
#pragma unroll
          for (int j = 0; j < 4; ++j) { const u32x2 h2 = *(const u32x2*)(hp + j * 256 + lane * 4); const f32x4 gg = *(const f32x4*)(a.final_norm + j * 256 + lane * 4);
              f32x4 v = {bflo(h2.x), bfhi(h2.x), bflo(h2.y), bfhi(h2.y)}; v = v * rs * gg; *(f32x4*)(p + j * 256 + lane * 4) = v; } } }
}

extern "C" void kernel_launch(void* const* d_in, const int* in_sizes, int n_in, void* d_out, int out_size, void* d_ws, size_t ws_size, hipStream_t stream) {
    static int grid_blocks = 0;
    if (!grid_blocks) {
        int dev = 0, cus = 0, per_cu = 0;
        hipGetDevice(&dev);
        hipDeviceGetAttribute(&cus, hipDeviceAttributeMultiprocessorCount, dev);
        hipFuncSetAttribute((const void*)fwd_kernel, hipFuncAttributeMaxDynamicSharedMemorySize, LDS_BYTES);
        hipOccupancyMaxActiveBlocksPerMultiprocessor(&per_cu, (const void*)fwd_kernel, 512, LDS_BYTES);
        if (per_cu < 1) { fprintf(stderr, "occupancy query returned %d\n", per_cu); per_cu = 1; }
        grid_blocks = cus * per_cu;
        if (ws_size < WS_END) fprintf(stderr, "workspace too small: %zu < %zu\n", ws_size, (size_t)WS_END);
    }
    Args a{};
    const float** f = (const float**)&a;
    for (int i = 0; i < 22; ++i) f[i] = (const float*)d_in[i];
    a.out = (float*)d_out; a.ws = (unsigned char*)d_ws;
    hipMemsetAsync((char*)d_ws + OFF_BAR, 0, 16384, stream);
    void* args[] = {&a};
    hipError_t e = hipLaunchCooperativeKernel((const void*)fwd_kernel, dim3(grid_blocks), dim3(512), args, LDS_BYTES, stream);
    if (e != hipSuccess) fprintf(stderr, "cooperative launch failed: %s (grid %d)\n", hipGetErrorString(e), grid_blocks);
}
```
